# Optimizing an MI355X kernel written in HIP

```python
import math
import jax, jax.numpy as jnp
from jax import lax
import numpy as np

D_MODEL = 1024
BATCH = 2
SEQ = 8192
DEPTH = 4
DEC_BATCH = 128
DEC_SEQ = 1
PAST_LEN = 8192
PAGE_SIZE = 128

N_META = 16
HEAD_DIM = 64
ATT_WIDTH = D_MODEL // 2
ATT_HEADS = ATT_WIDTH // HEAD_DIM
ATT_KV_HEADS = ATT_HEADS // 4
KV_WIDTH = ATT_KV_HEADS * HEAD_DIM
WINDOW = 128
ATT_BLOCK = 128
ROPE_THETA = 10000.0
S5_WIDTH = D_MODEL // 4
S5_GROUP_CH = 16
S5_GROUPS = S5_WIDTH // S5_GROUP_CH
S5_STATE = 64
SSD_WIDTH = D_MODEL // 4
SSD_HEAD_DIM = 64
SSD_HEADS = SSD_WIDTH // SSD_HEAD_DIM
SSD_GROUPS = 2
SSD_STATE = 64
SSD_CONV = 4
SSD_CHUNK = 128
SSD_CONV_DIM = SSD_WIDTH + 2 * SSD_GROUPS * SSD_STATE
MIX_WIDTH = ATT_WIDTH + S5_WIDTH + SSD_WIDTH
N_IN = ATT_WIDTH + 2 * KV_WIDTH + S5_WIDTH + SSD_WIDTH + SSD_CONV_DIM + SSD_HEADS
FFN_HIDDEN = ((8 * D_MODEL + 3 * 256 - 1) // (3 * 256)) * 256
NORM_EPS = 1e-6

kernel_name = "hymba_swa_s5_ssd_decoder_step"

F32 = jnp.float32


def rmsnorm(x, g):
    xf = x.astype(F32)
    y = xf * lax.rsqrt(jnp.mean(xf * xf, axis=-1, keepdims=True) + NORM_EPS)
    return (y * g.astype(F32)).astype(x.dtype)


def rope(x, pos):
    half = HEAD_DIM // 2
    inv = ROPE_THETA ** (-jnp.arange(half, dtype=F32) / half)
    ang = pos.astype(F32)[:, None] * inv[None, :]
    cos = jnp.cos(ang)[:, None, :]
    sin = jnp.sin(ang)[:, None, :]
    xf = x.astype(F32)
    x1, x2 = xf[..., :half], xf[..., half:]
    return jnp.concatenate([x1 * cos - x2 * sin, x2 * cos + x1 * sin], axis=-1).astype(x.dtype)


def sink_attention(q, k, v, qpos, kpos, sinks):
    *lead, tq, nh, hd = q.shape
    kvh = k.shape[-2]
    rep = nh // kvh
    qg = q.reshape(*lead, tq, kvh, rep, hd)
    s = jnp.einsum('...qgrd,...kgd->...grqk', qg, k, preferred_element_type=F32) * (hd ** -0.5)
    delta = qpos[..., :, None] - kpos[..., None, :]
    ok = (delta >= 0) & (delta <= WINDOW) & (kpos[..., None, :] >= 0)
    s = jnp.where(ok[..., None, None, :, :], s, -jnp.inf)
    sink = sinks.astype(F32).reshape(kvh, rep)[:, :, None, None]
    m = jnp.maximum(jnp.max(s, axis=-1, keepdims=True), sink)
    p = jnp.exp(s - m)
    den = jnp.sum(p, axis=-1, keepdims=True) + jnp.exp(sink - m)
    w = (p / den).astype(v.dtype)
    o = jnp.einsum('...grqk,...kgd->...qgrd', w, v)
    return o.reshape(*lead, tq, nh * hd)


def attn_prompt(q, k, v, sinks):
    b, L = q.shape[:2]
    front = ATT_BLOCK - N_META
    pad = lambda t: jnp.pad(t, ((0, 0), (front, 0), (0, 0), (0, 0)))
    qp, kp, vp = pad(q), pad(k), pad(v)
    Lp = L + front
    nb = Lp // ATT_BLOCK
    pos = jnp.arange(Lp, dtype=jnp.int32) - front
    qb = qp.reshape(b, nb, ATT_BLOCK, ATT_HEADS, HEAD_DIM)
    kb = kp.reshape(b, nb, ATT_BLOCK, ATT_KV_HEADS, HEAD_DIM)
    vb = vp.reshape(b, nb, ATT_BLOCK, ATT_KV_HEADS, HEAD_DIM)
    two = lambda t: jnp.concatenate(
        [jnp.pad(t[:, :-1], ((0, 0), (1, 0), (0, 0), (0, 0), (0, 0))), t], axis=2)
    kk, vv = two(kb), two(vb)
    pb = pos.reshape(nb, ATT_BLOCK)
    kpos = jnp.concatenate([jnp.pad(pb[:-1], ((1, 0), (0, 0)), constant_values=-1), pb], axis=1)
    o = sink_attention(qb, kk, vv, pb, kpos, sinks)
    return o.reshape(b, Lp, ATT_WIDTH)[:, front:]


def attn_sample(q, k, v, ck, cv, sinks):
    T = q.shape[1]
    W = ck.shape[1]
    qpos = PAST_LEN + jnp.arange(T, dtype=jnp.int32)
    kpos = jnp.concatenate([PAST_LEN - W + jnp.arange(W, dtype=jnp.int32), qpos])
    kk = jnp.concatenate([ck.astype(k.dtype), k], axis=1)
    vv = jnp.concatenate([cv.astype(v.dtype), v], axis=1)
    o = sink_attention(q, kk, vv, qpos, kpos, sinks)
    return o, kk[:, -W:], vv[:, -W:]


def s5_scan(u, h0_re, h0_im, a_re, a_im, log_dt, b_re, b_im, c_re, c_im, d):
    dt = jnp.exp(log_dt.astype(F32))[:, None]
    ar, ai = a_re.astype(F32), a_im.astype(F32)
    mag = jnp.exp(dt * ar)
    abar_re, abar_im = mag * jnp.cos(dt * ai), mag * jnp.sin(dt * ai)
    den = ar * ar + ai * ai
    xr = abar_re - 1.0
    f_re = (xr * ar + abar_im * ai) / den
    f_im = (abar_im * ar - xr * ai) / den
    br, bi = b_re.astype(F32), b_im.astype(F32)
    bb_re = f_re[..., None] * br - f_im[..., None] * bi
    bb_im = f_re[..., None] * bi + f_im[..., None] * br
    bu_re = jnp.einsum('gnc,btgc->btgn', bb_re, u)
    bu_im = jnp.einsum('gnc,btgc->btgn', bb_im, u)
    a_re_t = jnp.broadcast_to(abar_re, bu_re.shape)
    a_im_t = jnp.broadcast_to(abar_im, bu_re.shape)

    def combine(e1, e2):
        a1r, a1i, b1r, b1i = e1
        a2r, a2i, b2r, b2i = e2
        return (a2r * a1r - a2i * a1i, a2r * a1i + a2i * a1r,
                a2r * b1r - a2i * b1i + b2r, a2r * b1i + a2i * b1r + b2i)

    cr, ci, hr, hi = lax.associative_scan(combine, (a_re_t, a_im_t, bu_re, bu_im), axis=1)
    h0r = h0_re.astype(F32)[:, None]
    h0i = h0_im.astype(F32)[:, None]
    hr = hr + cr * h0r - ci * h0i
    hi = hi + cr * h0i + ci * h0r
    y = (jnp.einsum('gcn,btgn->btgc', c_re.astype(F32), hr)
         - jnp.einsum('gcn,btgn->btgc', c_im.astype(F32), hi)
         + d.astype(F32).reshape(S5_GROUPS, S5_GROUP_CH) * u)
    return y, hr[:, -1], hi[:, -1]


def causal_conv(xbc, conv_state, w, bias):
    T = xbc.shape[1]
    xp = jnp.concatenate([conv_state.astype(xbc.dtype), xbc], axis=1)
    out = bias
    for j in range(SSD_CONV):
        out = out + xp[:, j:j + T] * w[j]
    return jax.nn.silu(out), xp[:, -(SSD_CONV - 1):]


def ssd_scan(x, dt, A, Bm, Cm, Dh, h0, front):
    b, T = x.shape[:2]
    total = front + T
    q = min(SSD_CHUNK, total)
    back = (-total) % q
    padt = lambda t: jnp.pad(t, [(0, 0), (front, back)] + [(0, 0)] * (t.ndim - 2))
    x, dt, Bm, Cm = padt(x), padt(dt), padt(Bm), padt(Cm)
    nc = (total + back) // q
    rep = SSD_HEADS // SSD_GROUPS
    ch = lambda t: t.reshape(b, nc, q, *t.shape[2:])
    Bc = ch(jnp.repeat(Bm, rep, axis=2))
    Cc = ch(jnp.repeat(Cm, rep, axis=2))
    xd = ch(x * dt[..., None])
    cs = jnp.cumsum(ch(dt * A), axis=2)
    seg = cs[:, :, :, None, :] - cs[:, :, None, :, :]
    causal = jnp.tril(jnp.ones((q, q), dtype=bool))[None, None, :, :, None]
    Lmat = jnp.exp(jnp.where(causal, seg, -jnp.inf))
    scores = jnp.einsum('bcihn,bcjhn->bcijh', Cc, Bc) * Lmat
    y_diag = jnp.einsum('bcijh,bcjhp->bcihp', scores, xd)
    decay = jnp.exp(cs[:, :, -1:, :] - cs)
    states = jnp.einsum('bcjhn,bcjh,bcjhp->bchpn', Bc, decay, xd)
    chunk_decay = jnp.exp(cs[:, :, -1, :])

    def step(h, inp):
        dcy, st = inp
        return dcy[:, :, None, None] * h + st, h

    h_last, h_prev = lax.scan(step, h0.astype(F32),
                              (jnp.moveaxis(chunk_decay, 1, 0), jnp.moveaxis(states, 1, 0)))
    h_prev = jnp.moveaxis(h_prev, 0, 1)
    y_off = jnp.einsum('bcihn,bchpn,bcih->bcihp', Cc, h_prev, jnp.exp(cs))
    y = (y_diag + y_off).reshape(b, nc * q, SSD_HEADS, SSD_HEAD_DIM) + Dh.astype(F32)[:, None] * x
    return y[:, front:front + T], h_last


def token_mixers(hn, lp, st, prompt):
    ck, cv, s5r0, s5i0, conv0, ssd0 = st
    b, T, _ = hn.shape
    sizes = (ATT_WIDTH, KV_WIDTH, KV_WIDTH, S5_WIDTH, SSD_WIDTH, SSD_CONV_DIM, SSD_HEADS)
    offs = [int(o) for o in np.cumsum(sizes)[:-1]]
    proj = hn @ lp['w_in']
    q, k, v, u, z, xbc, dtr = jnp.split(proj, offs, axis=-1)

    pos = jnp.arange(T, dtype=jnp.int32) + (0 if prompt else PAST_LEN)
    q = rope(q.reshape(b, T, ATT_HEADS, HEAD_DIM), pos)
    k = rope(k.reshape(b, T, ATT_KV_HEADS, HEAD_DIM), pos)
    v = v.reshape(b, T, ATT_KV_HEADS, HEAD_DIM)
    if prompt:
        o_att = attn_prompt(q, k, v, lp['attn_sinks'])
        nk, nv = k[:, -WINDOW:], v[:, -WINDOW:]
    else:
        o_att, nk, nv = attn_sample(q, k, v, ck, cv, lp['attn_sinks'])
    o_att = rmsnorm(o_att, lp['attn_out_g'])

    y5, s5r, s5i = s5_scan(u.astype(F32).reshape(b, T, S5_GROUPS, S5_GROUP_CH), s5r0, s5i0,
                           lp['s5_a_re'], lp['s5_a_im'], lp['s5_log_dt'], lp['s5_b_re'], lp['s5_b_im'],
                           lp['s5_c_re'], lp['s5_c_im'], lp['s5_d'])
    y5 = jax.nn.gelu(y5.reshape(b, T, S5_WIDTH))
    y5 = y5 * jax.nn.sigmoid(y5 @ lp['s5_glu_w'].astype(F32) + lp['s5_glu_b'].astype(F32))
    o_s5 = rmsnorm(y5, lp['s5_out_g']).astype(hn.dtype)

    xbc, nconv = causal_conv(xbc, conv0, lp['ssd_conv_w'], lp['ssd_conv_b'])
    xs, bm, cm = jnp.split(xbc, [SSD_WIDTH, SSD_WIDTH + SSD_GROUPS * SSD_STATE], axis=-1)
    dt = jax.nn.softplus(dtr.astype(F32) + lp['ssd_dt_bias'].astype(F32))
    A = -jnp.exp(lp['ssd_a_log'].astype(F32))
    front = SSD_CHUNK - N_META if prompt else 0
    yc, hssd = ssd_scan(xs.astype(F32).reshape(b, T, SSD_HEADS, SSD_HEAD_DIM), dt, A,
                        bm.astype(F32).reshape(b, T, SSD_GROUPS, SSD_STATE),
                        cm.astype(F32).reshape(b, T, SSD_GROUPS, SSD_STATE),
                        lp['ssd_d'], ssd0, front)
    yc = yc.reshape(b, T, SSD_WIDTH) * jax.nn.silu(z.astype(F32))
    o_ssd = rmsnorm(yc, lp['ssd_norm_g']).astype(hn.dtype)

    mixed = jnp.concatenate([o_att, o_s5, o_ssd], axis=-1) @ lp['w_out']
    return mixed, (nk, nv, s5r, s5i, nconv, hssd)


def swiglu(h, wg, wu, wd):
    return (jax.nn.silu(h @ wg) * (h @ wu)) @ wd


def decoder_layer(x, lp, st, prompt):
    mixed, new_st = token_mixers(rmsnorm(x, lp['ln1_g']), lp, st, prompt)
    x = x + mixed
    x = x + swiglu(rmsnorm(x, lp['ln2_g']), lp['w_gate'], lp['w_up'], lp['w_down'])
    return x, new_st


def setup_inputs(seed: int = 0) -> dict:
    key = jax.random.key(seed)
    ks = iter(jax.random.split(key, 48))
    nrm = lambda shape, scale: jax.random.normal(next(ks), shape, F32) * scale
    unif = lambda shape, lo, hi: jax.random.uniform(next(ks), shape, F32, lo, hi)
    w_c = min(WINDOW, PAST_LEN)
    n_idx = jnp.arange(S5_STATE, dtype=F32)
    dt0 = jnp.exp(unif((DEPTH, SSD_HEADS), math.log(1e-3), math.log(1e-1)))
    return {
        'x_prompt': nrm((BATCH, SEQ, D_MODEL), 1.0),
        'x_sample': nrm((DEC_BATCH, DEC_SEQ, D_MODEL), 1.0),
        'cache_k': nrm((DEPTH, DEC_BATCH, w_c, ATT_KV_HEADS, HEAD_DIM), 1.0),
        'cache_v': nrm((DEPTH, DEC_BATCH, w_c, ATT_KV_HEADS, HEAD_DIM), 1.0),
        'state_s5_re': nrm((DEPTH, DEC_BATCH, S5_GROUPS, S5_STATE), 0.1),
        'state_s5_im': nrm((DEPTH, DEC_BATCH, S5_GROUPS, S5_STATE), 0.1),
        'state_ssd_conv': nrm((DEPTH, DEC_BATCH, SSD_CONV - 1, SSD_CONV_DIM), 1.0),
        'state_ssd': nrm((DEPTH, DEC_BATCH, SSD_HEADS, SSD_HEAD_DIM, SSD_STATE), 0.1),
        'meta_tokens': nrm((N_META, D_MODEL), 1.0),
        'ln1_g': 1.0 + nrm((DEPTH, D_MODEL), 0.02),
        'w_in': nrm((DEPTH, D_MODEL, N_IN), D_MODEL ** -0.5),
        'attn_sinks': nrm((DEPTH, ATT_HEADS), 0.5),
        'attn_out_g': 1.0 + nrm((DEPTH, ATT_WIDTH), 0.02),
        's5_a_re': -0.5 + nrm((DEPTH, S5_GROUPS, S5_STATE), 0.01),
        's5_a_im': math.pi * n_idx + nrm((DEPTH, S5_GROUPS, S5_STATE), 0.01),
        's5_log_dt': unif((DEPTH, S5_GROUPS), math.log(1e-3), math.log(1e-1)),
        's5_b_re': nrm((DEPTH, S5_GROUPS, S5_STATE, S5_GROUP_CH), (2 * S5_GROUP_CH) ** -0.5),
        's5_b_im': nrm((DEPTH, S5_GROUPS, S5_STATE, S5_GROUP_CH), (2 * S5_GROUP_CH) ** -0.5),
        's5_c_re': nrm((DEPTH, S5_GROUPS, S5_GROUP_CH, S5_STATE), (2 * S5_STATE) ** -0.5),
        's5_c_im': nrm((DEPTH, S5_GROUPS, S5_GROUP_CH, S5_STATE), (2 * S5_STATE) ** -0.5),
        's5_d': nrm((DEPTH, S5_WIDTH), 1.0),
        's5_glu_w': nrm((DEPTH, S5_WIDTH, S5_WIDTH), S5_WIDTH ** -0.5),
        's5_glu_b': nrm((DEPTH, S5_WIDTH), 0.01),
        's5_out_g': 1.0 + nrm((DEPTH, S5_WIDTH), 0.02),
        'ssd_conv_w': nrm((DEPTH, SSD_CONV, SSD_CONV_DIM), SSD_CONV ** -0.5),
        'ssd_conv_b': nrm((DEPTH, SSD_CONV_DIM), 0.01),
        'ssd_dt_bias': dt0 + jnp.log(-jnp.expm1(-dt0)),
        'ssd_a_log': jnp.log(unif((DEPTH, SSD_HEADS), 1.0, 16.0)),
        'ssd_d': 1.0 + nrm((DEPTH, SSD_HEADS), 0.02),
        'ssd_norm_g': 1.0 + nrm((DEPTH, SSD_WIDTH), 0.02),
        'w_out': nrm((DEPTH, MIX_WIDTH, D_MODEL), MIX_WIDTH ** -0.5),
        'ln2_g': 1.0 + nrm((DEPTH, D_MODEL), 0.02),
        'w_gate': nrm((DEPTH, D_MODEL, FFN_HIDDEN), D_MODEL ** -0.5),
        'w_up': nrm((DEPTH, D_MODEL, FFN_HIDDEN), D_MODEL ** -0.5),
        'w_down': nrm((DEPTH, FFN_HIDDEN, D_MODEL), FFN_HIDDEN ** -0.5),
        'lnf_g': 1.0 + nrm((D_MODEL,), 0.02),
    }


def reference(x_prompt, x_sample, cache_k, cache_v, state_s5_re, state_s5_im, state_ssd_conv, state_ssd,
              meta_tokens, ln1_g, w_in, attn_sinks, attn_out_g, s5_a_re, s5_a_im, s5_log_dt,
              s5_b_re, s5_b_im, s5_c_re, s5_c_im, s5_d, s5_glu_w, s5_glu_b, s5_out_g,
              ssd_conv_w, ssd_conv_b, ssd_dt_bias, ssd_a_log, ssd_d, ssd_norm_g, w_out,
              ln2_g, w_gate, w_up, w_down, lnf_g):
    b = x_prompt.shape[0]
    meta = jnp.broadcast_to(meta_tokens[None].astype(x_prompt.dtype), (b, N_META, D_MODEL))
    xp = jnp.concatenate([meta, x_prompt], axis=1)
    xs = x_sample
    named = (('ln1_g', ln1_g), ('w_in', w_in), ('attn_sinks', attn_sinks), ('attn_out_g', attn_out_g),
             ('s5_a_re', s5_a_re), ('s5_a_im', s5_a_im), ('s5_log_dt', s5_log_dt),
             ('s5_b_re', s5_b_re), ('s5_b_im', s5_b_im), ('s5_c_re', s5_c_re), ('s5_c_im', s5_c_im),
             ('s5_d', s5_d), ('s5_glu_w', s5_glu_w), ('s5_glu_b', s5_glu_b), ('s5_out_g', s5_out_g),
             ('ssd_conv_w', ssd_conv_w), ('ssd_conv_b', ssd_conv_b), ('ssd_dt_bias', ssd_dt_bias),
             ('ssd_a_log', ssd_a_log), ('ssd_d', ssd_d), ('ssd_norm_g', ssd_norm_g), ('w_out', w_out),
             ('ln2_g', ln2_g), ('w_gate', w_gate), ('w_up', w_up), ('w_down', w_down))
    new_p = [[] for _ in range(6)]
    new_s = [[] for _ in range(6)]
    for l in range(DEPTH):
        lp = {name: arr[l] for name, arr in named}
        st_p = (None, None,
                jnp.zeros((b, S5_GROUPS, S5_STATE), F32), jnp.zeros((b, S5_GROUPS, S5_STATE), F32),
                jnp.zeros((b, SSD_CONV - 1, SSD_CONV_DIM), xp.dtype),
                jnp.zeros((b, SSD_HEADS, SSD_HEAD_DIM, SSD_STATE), F32))
        xp, sp = decoder_layer(xp, lp, st_p, True)
        st_s = (cache_k[l], cache_v[l], state_s5_re[l], state_s5_im[l], state_ssd_conv[l], state_ssd[l])
        xs, ss = decoder_layer(xs, lp, st_s, False)
        for i in range(6):
            new_p[i].append(sp[i])
            new_s[i].append(ss[i])
    y_prompt = rmsnorm(xp, lnf_g)[:, N_META:]
    y_sample = rmsnorm(xs, lnf_g)
    k_p, v_p, s5re_p, s5im_p, conv_p, ssd_p = [jnp.stack(t) for t in new_p]
    k_s, v_s, s5re_s, s5im_s, conv_s, ssd_s = [jnp.stack(t) for t in new_s]
    return (y_prompt, y_sample, k_p, v_p, s5re_p, s5im_p, conv_p, ssd_p,
            k_s, v_s, s5re_s, s5im_s, conv_s, ssd_s)
```

```cpp
#define MK_ONE_LAUNCH 1
#include <hip/hip_runtime.h>
#include <hip/hip_cooperative_groups.h>
#include <cstdio>
#include <cstdint>
namespace cg = cooperative_groups;

#define LAS __attribute__((address_space(3)))
typedef unsigned short bf16_t;
typedef short bf16x8 __attribute__((ext_vector_type(8)));
typedef short bf16x4 __attribute__((ext_vector_type(4)));
typedef float f32x4 __attribute__((ext_vector_type(4)));
typedef float f32x2 __attribute__((ext_vector_type(2)));
typedef float f32x16 __attribute__((ext_vector_type(16)));
typedef unsigned u32x4 __attribute__((ext_vector_type(4)));
typedef unsigned u32x2 __attribute__((ext_vector_type(2)));

constexpr int DM = 1024, NL = 4, SEQ = 8192, NMETA = 16, TT = SEQ + NMETA  , NB = 2, NS = 128;
constexpr int MR = 16640;
constexpr int R_META = 16384, R_SAMP = 16416, R_VALID = 16544;
constexpr int BPAD = 8320;
constexpr int PR = 2 * BPAD + NS;
constexpr int PR_SAMP = 2 * BPAD;
constexpr int NIN = 1792, NINSRC = 1796, FFN = 2816, NGU = 2 * FFN;
constexpr int NCH = 65;
constexpr int NCH5 = 130;
constexpr float EPS = 1e-6f;

constexpr size_t O_Y = 0, O_YS = 16777216, O_KP = 16908288, O_VP = 17039360, O_S5RP = 17170432, O_S5IP = 17178624, O_CONVP = 17186816,
                 O_SSDP = 17199104, O_KS = 17330176, O_VS = 25718784, O_S5RS = 34107392, O_S5IS = 34631680, O_CONVS = 35155968, O_SSDS = 35942400,
                 O_END = 44331008;

constexpr size_t MiB = 1u << 20;
constexpr size_t WS_CTL = 0;
constexpr size_t WS_WIN = 1 * MiB;
constexpr size_t WS_WOUT = 15 * MiB;
constexpr size_t WS_WGU = 23 * MiB;
constexpr size_t WS_WDN = 67 * MiB;
constexpr size_t WS_TAB = 89 * MiB;
constexpr size_t TAB_ROPEC = WS_TAB;
constexpr size_t TAB_ROPES = TAB_ROPEC + 8208 * 32 * 4;
constexpr size_t TAB_ABAR = TAB_ROPES + 8208 * 32 * 4;
constexpr size_t TAB_A64 = TAB_ABAR + 4 * 16 * 64 * 2 * 4;
constexpr size_t TAB_BBF = TAB_A64 + 4 * 16 * 64 * 2 * 4;
constexpr size_t TAB_BBP = TAB_BBF + 4 * 16 * 64 * 32 * 4;
constexpr size_t TAB_CC = TAB_BBP + 4 * 8 * 256 * 32 * 2;
constexpr size_t TAB_GLUT = TAB_CC + 4 * 16 * 16 * 128 * 2;
constexpr size_t TAB_WDT = TAB_GLUT + 4 * 256 * 256 * 2;
constexpr size_t TAB_END = TAB_WDT + 4 * 4 * 1024 * 4;
static_assert(TAB_END <= WS_TAB + 8 * MiB, "tables");
constexpr size_t WS_SSQ = 97 * MiB;
constexpr size_t WS_XF = 98 * MiB;
constexpr size_t WS_XB = 163 * MiB;
constexpr size_t WS_MIX = 196 * MiB;
constexpr size_t WS_R = 229 * MiB;
constexpr size_t WS_H = WS_R;
constexpr size_t WS_Q = WS_R;
constexpr size_t WS_K = WS_Q + (size_t)PR * 512 * 2;
constexpr size_t WS_VT = WS_K + (size_t)PR * 128 * 2;
constexpr size_t WS_U = WS_VT + (size_t)PR * 128 * 2;
constexpr size_t WS_Z = WS_U + (size_t)PR * 256 * 4;
constexpr size_t WS_XBC = WS_Z + (size_t)PR * 256 * 2;
constexpr size_t WS_XC = WS_XBC + (size_t)PR * 512 * 2;
constexpr size_t WS_DT = WS_XC + (size_t)PR * 512 * 2;
constexpr size_t WS_DTS = WS_DT + (size_t)PR * 4 * 4;
constexpr size_t WS_CS = WS_DTS + (size_t)PR * 4 * 4;
constexpr size_t WS_E5 = WS_CS + (size_t)PR * 4 * 4;
constexpr size_t WS_SLOC = WS_E5 + (size_t)2 * NCH5 * 16 * 64 * 2 * 4;
constexpr size_t WS_HP = WS_SLOC + (size_t)2 * NCH * 4 * 4096 * 4;
constexpr size_t WS_CD = WS_HP + (size_t)2 * NCH * 4 * 4096 * 4;
constexpr size_t WS_H05 = WS_CD + 4096;
constexpr size_t WS_MIXEND = WS_H05 + (size_t)2 * NCH5 * 16 * 64 * 2 * 4;
constexpr size_t WS_HEND = WS_R + (size_t)MR * FFN * 2;
constexpr size_t WS_END = WS_MIXEND > WS_HEND ? WS_MIXEND : WS_HEND;

__device__ __forceinline__ unsigned f2bf(float f) { unsigned u = __builtin_bit_cast(unsigned, f); return (u + 0x7fffu + ((u >> 16) & 1u)) >> 16; }
__device__ __forceinline__ unsigned pk2(float lo, float hi) { return f2bf(lo) | (f2bf(hi) << 16); }
__device__ __forceinline__ float bf2f(unsigned short b) { return __builtin_bit_cast(float, (unsigned)b << 16); }
__device__ __forceinline__ float bflo(unsigned w) { return __builtin_bit_cast(float, w << 16); }
__device__ __forceinline__ float bfhi(unsigned w) { return __builtin_bit_cast(float, w & 0xffff0000u); }
__device__ __forceinline__ float wave_sum(float v) {
#pragma unroll
    for (int o = 1; o < 64; o <<= 1) v += __shfl_xor(v, o);
    return v;
}
__device__ __forceinline__ float wave_max(float v) {
#pragma unroll
    for (int o = 1; o < 64; o <<= 1) v = fmaxf(v, __shfl_xor(v, o));
    return v;
}
__device__ __forceinline__ float sigmoidf_(float x) { return 1.0f / (1.0f + __expf(-x)); }
__device__ __forceinline__ float siluf_(float x) { return x / (1.0f + __expf(-x)); }
__device__ __forceinline__ float softplusf_(float x) { return fmaxf(x, 0.f) + __logf(1.0f + __expf(-fabsf(x))); }
__device__ __forceinline__ float gelu_tanh(float x) {
    const float u = 0.7978845608028654f * (x + 0.044715f * x * x * x);
    const float e = __expf(2.0f * u);
    const float t = 1.0f - 2.0f / (e + 1.0f);
    return 0.5f * x * (1.0f + t);
}
__device__ __forceinline__ void sincos_red(double ang, float& s, float& c) {
    const double k = __builtin_rint(ang * 0.15915494309189535);
    const double r = __builtin_fma(-k, 6.283185307179586, ang) - k * 2.4492935982947064e-16;
    const float rf = (float)r;
    s = sinf(rf); c = cosf(rf);
}
__device__ __forceinline__ int row_to_pr(int r, int& pos) {
    if (r < R_META) { const int b = r >> 13, s = r & 8191; pos = s + 16; return b * BPAD + 128 + s; }
    if (r < R_SAMP) { const int b = (r - R_META) >> 4, t = (r - R_META) & 15; pos = t; return b * BPAD + 112 + t; }
    if (r < R_VALID) { pos = SEQ; return PR_SAMP + (r - R_SAMP); }
    pos = 0; return -1;
}
__device__ __forceinline__ int pr_to_row(int pr) {
    const int b = pr >= BPAD ? 1 : 0, lq = pr - b * BPAD, t = lq - 112;
    if (t < 0) return -1;
    return t < 16 ? R_META + b * 16 + t : b * SEQ + (t - 16);
}
__device__ __forceinline__ bf16x8 ld_bf16x8_f32(const float* p) {
    const f32x4 a = *(const f32x4*)p, b = *(const f32x4*)(p + 4);
    u32x4 w; w.x = pk2(a.x, a.y); w.y = pk2(a.z, a.w); w.z = pk2(b.x, b.y); w.w = pk2(b.z, b.w);
    return __builtin_bit_cast(bf16x8, w);
}
__device__ __forceinline__ int launder_tid() { int t = threadIdx.x; asm volatile("" : "+v"(t)); return t; }
__device__ __forceinline__ size_t ws_u_off(int l) {
#ifdef DBG_USPLIT
    return l == 0 ? WS_U : WS_WGU + 24 * MiB;
#else
    return WS_U;
#endif
}
__device__ __forceinline__ size_t ws_e5_off(int l) {
#ifdef DBG_E5SPLIT
    return l == 0 ? WS_E5 : WS_WGU + 24 * MiB;
#else
    return WS_E5;
#endif
}
__device__ __forceinline__ int launder_bid() { int t = blockIdx.x; asm volatile("" : "+s"(t)); return t; }
__device__ __forceinline__ int launder_gdim() { int t = gridDim.x; asm volatile("" : "+s"(t)); return t; }
#define MFMA16(a, b, c) __builtin_amdgcn_mfma_f32_16x16x32_bf16((a), (b), (c), 0, 0, 0)
#define MFMA32(a, b, c) __builtin_amdgcn_mfma_f32_32x32x16_bf16((a), (b), (c), 0, 0, 0)
#ifdef DBG_NOSETTLE
#define MFMA_SETTLE(x) do {} while (0)
#else
#define MFMA_SETTLE(x) asm volatile("s_nop 15\n\ts_nop 15" : "+v"(x))
#endif
#define LDS_WAIT() asm volatile("s_waitcnt lgkmcnt(0)" ::: "memory")

namespace pg8 {
#define PG8_LAS __attribute__((address_space(3)))
typedef unsigned short bf16_t;
typedef short bf16x8 __attribute__((ext_vector_type(8)));
typedef float f32x4 __attribute__((ext_vector_type(4)));
typedef unsigned u32x4 __attribute__((ext_vector_type(4)));
constexpr int BM = 256, BK = 64, HALF = 128, HTB = HALF * BK * 2  , STAGE_BYTES = 8 * HTB, NXCD = 8, WGM = 8;

__host__ __device__ __forceinline__ int lds_byte(int r, int c) { const int st = (r >> 4) * 2 + (c >> 5), rr = r & 15, cc = c & 31, ob = rr * 64 + cc * 2; return st * 1024 + (ob ^ (((ob >> 9) & 1) << 5)); }
__host__ __device__ __forceinline__ void stage_rc(int b, int& R, int& C) { const int st = b / 1024, sb = b % 1024, swz = sb ^ (((sb >> 9) & 1) << 5); R = (st >> 1) * 16 + swz / 64; C = (st & 1) * 32 + (swz % 64) / 2; }
__host__ __device__ __forceinline__ int perm32(int rho) { const int n = rho >> 4, i = rho & 15; return 8 * (i >> 2) + 4 * n + (i & 3); }

struct Unit { int pm, pn; };
struct Gemm { const bf16_t* A; const bf16_t* Bt; int M, N, K; };

struct StaticOrder {
    int nM, nN, nwg, G, c;
    __host__ __device__ void init(int M, int N, int G_, int c_) { nM = M / BM; nN = N / BM; nwg = nM * nN; G = G_; c = c_; }
    __host__ __device__ bool next(int i, Unit& u) const {
        const long L = (long)i * G + c; if (L >= nwg) return false;
        int wgid = (int)L; { const int q = nwg / NXCD, r = nwg % NXCD, xcd = wgid % NXCD, off = wgid / NXCD; wgid = (xcd < r ? xcd * (q + 1) : r * (q + 1) + (xcd - r) * q) + off; }
        const int nig = WGM * nN, gid = wgid / nig, fm = gid * WGM, gsz = (nM - fm) < WGM ? (nM - fm) : WGM;
        u.pm = fm + ((wgid % nig) % gsz); u.pn = (wgid % nig) / gsz; return true;
    }
    __device__ __forceinline__ void a_ready(const Unit&) const {}
    __device__ __forceinline__ void done(const Unit&) const {}
};

__device__ __forceinline__ unsigned cvt_pk_bf16(float lo, float hi) { unsigned r; asm volatile("v_cvt_pk_bf16_f32 %0, %1, %2" : "=v"(r) : "v"(lo), "v"(hi)); return r; }
template <class Epi, class Sched, bool ALIGN_EPI = false, bool SP2 = false>
__device__ __forceinline__ void gemm_phase(PG8_LAS unsigned char* lds, const Gemm g, const Sched& S, const Epi& E) {
    const int tid = launder_tid(), wid = __builtin_amdgcn_readfirstlane(tid >> 6), lane = tid & 63, wr = wid >> 2, wc = wid & 3, fr = lane & 15, fq = lane >> 4;
    const int K = g.K, nt = K / BK;
    unsigned voffA[2], voffB[2];
#pragma unroll
    for (int i = 0; i < 2; ++i) { int R, C; stage_rc(tid * 16 + i * 8192, R, C); const int Rb = Epi::PERM ? ((R & ~31) + perm32(R & 31)) : R;
        voffA[i] = (unsigned)(R * K + C) * 2u; voffB[i] = (unsigned)(Rb * K + C) * 2u; }
    const size_t kstep = (size_t)(BK * 2);
    const size_t hstep = (size_t)HALF * K * 2;
    const size_t tstep = 2 * hstep;
    const unsigned ldsw = (unsigned)wid * 1024u;
    const int aoff = lds_byte(wr * 64 + fr, fq * 8), boff = lds_byte(wc * 32 + fr, fq * 8);
#define PG8_SA(b, h) (((b) * 2 + (h)) * HTB)
#define PG8_SB(b, h) ((4 + (b) * 2 + (h)) * HTB)
#define PG8_STAGE(bufoff, gbase, voff) do { _Pragma("unroll") for (int _i = 0; _i < 2; ++_i) \
        __builtin_amdgcn_global_load_lds((const unsigned*)((const char*)(gbase) + (voff)[_i]), (PG8_LAS unsigned*)(lds + (bufoff) + ldsw + _i * 8192), 16, 0, 0); } while (0)
#define PG8_LDA(dst, b, h) do { _Pragma("unroll") for (int m = 0; m < 4; ++m) _Pragma("unroll") for (int k = 0; k < 2; ++k) dst[m][k] = *(const PG8_LAS bf16x8*)(lds + PG8_SA(b, h) + aoff + m * 2048 + k * 1024); } while (0)
#define PG8_LDB(dst, b, h) do { _Pragma("unroll") for (int n = 0; n < 2; ++n) _Pragma("unroll") for (int k = 0; k < 2; ++k) dst[n][k] = *(const PG8_LAS bf16x8*)(lds + PG8_SB(b, h) + boff + n * 2048 + k * 1024); } while (0)
#define PG8_MMA(ai, bj, At, Bt) do { __builtin_amdgcn_s_setprio(1); _Pragma("unroll") for (int m = 0; m < 4; ++m) _Pragma("unroll") for (int n = 0; n < 2; ++n) _Pragma("unroll") for (int k = 0; k < 2; ++k) \
        acc[ai][bj][m][n] = __builtin_amdgcn_mfma_f32_16x16x32_bf16(Bt[n][k], At[m][k], acc[ai][bj][m][n], 0, 0, 0); __builtin_amdgcn_s_setprio(0); } while (0)
#define PG8_WAIT_V(n) asm volatile("s_waitcnt vmcnt(" #n ")" ::: "memory")
#define PG8_WAIT_L(n) asm volatile("s_waitcnt lgkmcnt(" #n ")" ::: "memory")
#define PG8_BAR __builtin_amdgcn_s_barrier()
#define PG8_SCHED __builtin_amdgcn_sched_barrier(0)
    Unit cur, nxt; int ui = 0;
    if (!S.next(0, cur)) return;
    f32x4 acc[2][2][4][2];
#pragma unroll
    for (int a = 0; a < 2; ++a)
#pragma unroll
        for (int b = 0; b < 2; ++b)
#pragma unroll
            for (int m = 0; m < 4; ++m)
#pragma unroll
                for (int n = 0; n < 2; ++n) acc[a][b][m][n] = (f32x4){0.f, 0.f, 0.f, 0.f};
    bf16x8 At[4][2], B0[2][2], B1[2][2];
    const char* cA = (const char*)g.A + (size_t)cur.pm * tstep; const char* cB = (const char*)g.Bt + (size_t)cur.pn * tstep;
    S.a_ready(cur);
    if constexpr (SP2) {
        PG8_STAGE(PG8_SB(0, 0), cB, voffB); PG8_STAGE(PG8_SB(0, 1), cB + hstep, voffB); PG8_STAGE(PG8_SA(0, 0), cA, voffA); PG8_STAGE(PG8_SA(0, 1), cA + hstep, voffA);
        if (wr == 1) PG8_BAR;
        PG8_WAIT_V(2); PG8_BAR;
        PG8_STAGE(PG8_SB(1, 0), cB + kstep, voffB); PG8_STAGE(PG8_SA(1, 0), cA + kstep, voffA); PG8_STAGE(PG8_SB(1, 1), cB + hstep + kstep, voffB);
        PG8_WAIT_V(6); PG8_BAR;
    } else {
        PG8_STAGE(PG8_SB(0, 0), cB, voffB); PG8_STAGE(PG8_SA(0, 0), cA, voffA); PG8_STAGE(PG8_SB(0, 1), cB + hstep, voffB); PG8_STAGE(PG8_SA(0, 1), cA + hstep, voffA);
        if (wr == 1) PG8_BAR;
        PG8_WAIT_V(4); PG8_BAR;
        PG8_STAGE(PG8_SB(1, 0), cB + kstep, voffB); PG8_STAGE(PG8_SA(1, 0), cA + kstep, voffA); PG8_STAGE(PG8_SB(1, 1), cB + hstep + kstep, voffB);
        PG8_WAIT_V(6); PG8_BAR;
    }
    for (;;) {
        const bool has_next = S.next(ui + 1, nxt);
        const char* nA = has_next ? (const char*)g.A + (size_t)nxt.pm * tstep : cA; const char* nB = has_next ? (const char*)g.Bt + (size_t)nxt.pn * tstep : cB;
        for (int t = 0; t < nt; t += 2) {
            const bool last = (t == nt - 2);
            const char* a1 = cA + (size_t)(t + 1) * kstep;
            const char* a2 = last ? nA : cA + (size_t)(t + 2) * kstep; const char* b2 = last ? nB : cB + (size_t)(t + 2) * kstep;
            const char* a3 = a2 + kstep; const char* b3 = b2 + kstep;
            if (last && has_next) S.a_ready(nxt);
            if constexpr (SP2) {
            PG8_LDB(B0, 0, 0); PG8_LDB(B1, 0, 1); PG8_SCHED; PG8_LDA(At, 0, 0); PG8_STAGE(PG8_SA(1, 1), a1 + hstep, voffA);
            PG8_WAIT_V(8); PG8_WAIT_L(0); PG8_BAR; PG8_MMA(0, 0, At, B0); PG8_MMA(0, 1, At, B1); PG8_BAR; PG8_SCHED;
            PG8_LDA(At, 0, 1); PG8_STAGE(PG8_SB(0, 0), b2, voffB); PG8_STAGE(PG8_SB(0, 1), b2 + hstep, voffB); PG8_STAGE(PG8_SA(0, 0), a2, voffA);
            PG8_WAIT_V(8); PG8_WAIT_L(0); PG8_BAR; PG8_MMA(1, 0, At, B0); PG8_MMA(1, 1, At, B1); PG8_BAR; PG8_SCHED;
            PG8_LDB(B0, 1, 0); PG8_LDB(B1, 1, 1); PG8_SCHED; PG8_LDA(At, 1, 0); PG8_STAGE(PG8_SA(0, 1), a2 + hstep, voffA);
            PG8_WAIT_V(8); PG8_WAIT_L(0); PG8_BAR; PG8_MMA(0, 0, At, B0); PG8_MMA(0, 1, At, B1); PG8_BAR; PG8_SCHED;
            PG8_LDA(At, 1, 1); PG8_STAGE(PG8_SB(1, 0), b3, voffB); PG8_STAGE(PG8_SB(1, 1), b3 + hstep, voffB); PG8_STAGE(PG8_SA(1, 0), a3, voffA);
            PG8_WAIT_V(8); PG8_WAIT_L(0); PG8_BAR; PG8_MMA(1, 0, At, B0); PG8_MMA(1, 1, At, B1); PG8_BAR; PG8_SCHED;
            } else {
            PG8_LDB(B0, 0, 0); PG8_SCHED; PG8_LDA(At, 0, 0); PG8_STAGE(PG8_SA(1, 1), a1 + hstep, voffA);
            PG8_WAIT_L(8); PG8_BAR; PG8_WAIT_L(0); PG8_MMA(0, 0, At, B0); PG8_BAR; PG8_SCHED;
            PG8_LDB(B1, 0, 1); PG8_STAGE(PG8_SB(0, 0), b2, voffB);
            PG8_BAR; PG8_WAIT_L(0); PG8_MMA(0, 1, At, B1); PG8_BAR;
            PG8_LDA(At, 0, 1); PG8_STAGE(PG8_SA(0, 0), a2, voffA);
            PG8_BAR; PG8_WAIT_L(0); PG8_MMA(1, 0, At, B0); PG8_BAR; PG8_SCHED;
            PG8_STAGE(PG8_SB(0, 1), b2 + hstep, voffB);
            PG8_WAIT_V(6); PG8_BAR; PG8_MMA(1, 1, At, B1); PG8_BAR;
            PG8_LDB(B0, 1, 0); PG8_SCHED; PG8_LDA(At, 1, 0); PG8_STAGE(PG8_SA(0, 1), a2 + hstep, voffA);
            PG8_WAIT_L(8); PG8_BAR; PG8_WAIT_L(0); PG8_MMA(0, 0, At, B0); PG8_BAR; PG8_SCHED;
            PG8_LDB(B1, 1, 1); PG8_STAGE(PG8_SB(1, 0), b3, voffB);
            PG8_BAR; PG8_WAIT_L(0); PG8_MMA(0, 1, At, B1); PG8_BAR;
            PG8_LDA(At, 1, 1); PG8_STAGE(PG8_SA(1, 0), a3, voffA);
            PG8_BAR; PG8_WAIT_L(0); PG8_MMA(1, 0, At, B0); PG8_BAR; PG8_SCHED;
            PG8_STAGE(PG8_SB(1, 1), b3 + hstep, voffB);
            PG8_WAIT_V(6); PG8_BAR; PG8_MMA(1, 1, At, B1); PG8_BAR;
            }
        }
        if constexpr (ALIGN_EPI) { if (wr == 0) PG8_BAR; }
        if constexpr (!Epi::AFTER_DRAIN) { E(acc, cur, wr, wc, fr, fq); S.done(cur); }
        if (!has_next) break;
#pragma unroll
        for (int a = 0; a < 2; ++a)
#pragma unroll
            for (int b = 0; b < 2; ++b)
#pragma unroll
                for (int m = 0; m < 4; ++m)
#pragma unroll
                    for (int n = 0; n < 2; ++n) acc[a][b][m][n] = (f32x4){0.f, 0.f, 0.f, 0.f};
        cur = nxt; cA = nA; cB = nB; ++ui;
        if constexpr (ALIGN_EPI) { if (wr == 1) PG8_BAR; }
    }
    PG8_WAIT_V(0);
    if constexpr (!ALIGN_EPI) { if (wr == 0) PG8_BAR; }
    PG8_BAR;
    if constexpr (Epi::AFTER_DRAIN) { E.fused(acc, cur, wr, wc, fr, fq, lds, wid, lane); S.done(cur); }
#undef PG8_SA
#undef PG8_SB
#undef PG8_STAGE
#undef PG8_LDA
#undef PG8_LDB
#undef PG8_MMA
#undef PG8_WAIT_V
#undef PG8_WAIT_L
#undef PG8_BAR
#undef PG8_SCHED
}
}

struct Params {
    const float* in[36];
    float* out;
    unsigned char* ws;
    int ph_lo, ph_hi;
    int dbg, pad0;
};
enum { I_XP = 0, I_XS, I_CK, I_CV, I_S5R, I_S5I, I_CONV, I_SSD, I_META, I_LN1, I_WIN, I_SINK, I_ATTG, I_ARE, I_AIM, I_LOGDT, I_BRE, I_BIM, I_CRE, I_CIM,
       I_S5D, I_GLUW, I_GLUB, I_S5G, I_CONVW, I_CONVB, I_DTB, I_ALOG, I_SSDD, I_SSDG, I_WOUT, I_LN2, I_WG, I_WU, I_WD, I_LNF };

constexpr int LDS_BYTES = 147456;
constexpr int LDS_RED = 131072;

__device__ __forceinline__ float row_rs(const float* ssq, int r) {
    const float s = (ssq[r] + ssq[MR + r]) + (ssq[2 * MR + r] + ssq[3 * MR + r]);
    return rsqrtf(s * (1.0f / DM) + EPS);
}

struct EpiWin {
    static constexpr bool PERM = false, AFTER_DRAIN = false;
    unsigned char* wsb; float* outb; int layer;
    __device__ __forceinline__ void operator()(const f32x4 (&acc)[2][2][4][2], const pg8::Unit& u, int wr, int wc, int fr, int fq) const {
        asm volatile("" : "+v"(fr), "+v"(fq));
        unsigned char* ws = wsb; float* out = outb; asm volatile("" : "+s"(ws), "+s"(out));
        const float* ssq = (const float*)(ws + WS_SSQ); bf16_t* Q = (bf16_t*)(ws + WS_Q); bf16_t* Kb = (bf16_t*)(ws + WS_K); bf16_t* Vt = (bf16_t*)(ws + WS_VT);
        bf16_t* Zb = (bf16_t*)(ws + WS_Z); bf16_t* XBCb = (bf16_t*)(ws + WS_XBC); float* U = (float*)(ws + ws_u_off(layer));
        const float* ropec = (const float*)(ws + TAB_ROPEC); const float* ropes = (const float*)(ws + TAB_ROPES);
        const int pn = u.pn;
#pragma unroll
        for (int ai = 0; ai < 2; ++ai)
#pragma unroll
            for (int m = 0; m < 4; ++m) {
                const int r = u.pm * 256 + ai * 128 + wr * 64 + m * 16 + fr;
                int pos; const int pr = row_to_pr(r, pos);
                if (pr < 0) continue;
                const float rs = row_rs(ssq, r);
                if (pn <= 2) {
                    const int d1 = 16 * (wc & 1) + 4 * fq;
                    const f32x4 c4 = *(const f32x4*)(ropec + (size_t)pos * 32 + d1), s4 = *(const f32x4*)(ropes + (size_t)pos * 32 + d1);
                    const int nb = pn < 2 ? 2 : 1;
#pragma unroll
                    for (int bj = 0; bj < 2; ++bj) {
                        if (bj >= nb) break;
                        const f32x4 x1 = acc[ai][bj][m][0] * rs, x2 = acc[ai][bj][m][1] * rs;
                        const f32x4 o1 = x1 * c4 - x2 * s4, o2 = x2 * c4 + x1 * s4;
                        u32x2 w1, w2; w1.x = pk2(o1.x, o1.y); w1.y = pk2(o1.z, o1.w); w2.x = pk2(o2.x, o2.y); w2.y = pk2(o2.z, o2.w);
                        if (pn < 2) {
                            const int head = 4 * pn + 2 * bj + (wc >> 1);
                            bf16_t* qp = Q + (size_t)pr * 512 + head * 64 + d1;
                            *(u32x2*)qp = w1; *(u32x2*)(qp + 32) = w2;
                        } else {
                            const int kvh = wc >> 1;
                            bf16_t* kp = Kb + (size_t)pr * 128 + kvh * 64 + d1;
                            *(u32x2*)kp = w1; *(u32x2*)(kp + 32) = w2;
                            if (r < R_META && pos >= TT - 128) {
                                float* o = out + O_KP + ((size_t)(layer * 2 + (r >> 13)) * 128 + (pos - (TT - 128))) * 128 + kvh * 64 + d1;
                                *(f32x4*)o = o1; *(f32x4*)(o + 32) = o2;
                            }
                            if (r >= R_SAMP) {
                                float* o = out + O_KS + (((size_t)layer * 128 + (r - R_SAMP)) * 128 + 127) * 128 + kvh * 64 + d1;
                                *(f32x4*)o = o1; *(f32x4*)(o + 32) = o2;
                            }
                        }
                    }
                    if (pn == 2) {
#pragma unroll
                        for (int n = 0; n < 2; ++n) {
                            const int c = 32 * wc + 16 * n + 4 * fq;
                            const f32x4 v = acc[ai][1][m][n] * rs;
                            bf16_t* vp = Vt + (size_t)c * PR + pr;
                            vp[0] = (bf16_t)f2bf(v.x); vp[PR] = (bf16_t)f2bf(v.y); vp[2 * (size_t)PR] = (bf16_t)f2bf(v.z); vp[3 * (size_t)PR] = (bf16_t)f2bf(v.w);
                            if (r < R_META && pos >= TT - 128)
                                *(f32x4*)(out + O_VP + ((size_t)(layer * 2 + (r >> 13)) * 128 + (pos - (TT - 128))) * 128 + c) = v;
                            if (r >= R_SAMP)
                                *(f32x4*)(out + O_VS + (((size_t)layer * 128 + (r - R_SAMP)) * 128 + 127) * 128 + c) = v;
                        }
                    }
                } else {
#pragma unroll
                    for (int bj = 0; bj < 2; ++bj)
#pragma unroll
                        for (int n = 0; n < 2; ++n) {
                            const int c = 128 * bj + 32 * wc + 16 * n + 4 * fq;
                            const f32x4 v = acc[ai][bj][m][n] * rs;
                            if (pn == 3) { *(f32x4*)(U + (size_t)pr * 256 + c) = v; }
                            else {
                                u32x2 w; w.x = pk2(v.x, v.y); w.y = pk2(v.z, v.w);
                                if (pn == 4) { *(u32x2*)(Zb + (size_t)pr * 256 + c) = w; }
                                else {
                                    const int cc = (pn - 5) * 256 + c;
                                    *(u32x2*)(XBCb + (size_t)pr * 512 + cc) = w;
                                    if (r < R_META && pos >= TT - 3)
                                        *(f32x4*)(out + O_CONVP + ((size_t)(layer * 2 + (r >> 13)) * 3 + (pos - (TT - 3))) * 512 + cc) = v;
                                    if (r >= R_SAMP)
                                        *(f32x4*)(out + O_CONVS + (((size_t)layer * 128 + (r - R_SAMP)) * 3 + 2) * 512 + cc) = v;
                                }
                            }
                        }
                }
            }
    }
};

struct EpiRes {
    static constexpr bool PERM = false, AFTER_DRAIN = false;
    unsigned char* wsb; LAS float* red;
    __device__ __forceinline__ void operator()(const f32x4 (&acc)[2][2][4][2], const pg8::Unit& u, int wr, int wc, int fr, int fq) const {
        asm volatile("" : "+v"(fr), "+v"(fq));
        unsigned char* ws = wsb; asm volatile("" : "+s"(ws));
        float* XF = (float*)(ws + WS_XF); bf16_t* XB = (bf16_t*)(ws + WS_XB); float* ssq = (float*)(ws + WS_SSQ);
        const int col0 = u.pn * 256 + wc * 32 + 4 * fq;
#pragma unroll
        for (int ai = 0; ai < 2; ++ai)
#pragma unroll
            for (int m = 0; m < 4; ++m) {
                const int rl = ai * 128 + wr * 64 + m * 16 + fr;
                const size_t off = (size_t)(u.pm * 256 + rl) * DM + col0;
                float q = 0.f;
#pragma unroll
                for (int bj = 0; bj < 2; ++bj)
#pragma unroll
                    for (int n = 0; n < 2; ++n) {
                        float* xp = XF + off + bj * 128 + n * 16;
                        f32x4 x = *(const f32x4*)xp; x = x + acc[ai][bj][m][n];
                        *(f32x4*)xp = x;
                        q += (x.x * x.x + x.y * x.y) + (x.z * x.z + x.w * x.w);
                        u32x2 w; w.x = pk2(x.x, x.y); w.y = pk2(x.z, x.w);
                        *(u32x2*)(XB + off + bj * 128 + n * 16) = w;
                    }
                q += __shfl_xor(q, 16); q += __shfl_xor(q, 32);
                if (fq == 0) red[rl * 4 + wc] = q;
            }
        LDS_WAIT(); __builtin_amdgcn_s_barrier(); asm volatile("" ::: "memory");
        const int t = launder_tid();
        if (t < 256) { const f32x4 v = *(const LAS f32x4*)(red + t * 4); ssq[(size_t)u.pn * MR + u.pm * 256 + t] = (v.x + v.y) + (v.z + v.w); }
        LDS_WAIT(); __builtin_amdgcn_s_barrier(); asm volatile("" ::: "memory");
    }
};

struct EpiGU {
    static constexpr bool PERM = false, AFTER_DRAIN = false;
    unsigned char* wsb;
    __device__ __forceinline__ void operator()(const f32x4 (&acc)[2][2][4][2], const pg8::Unit& u, int wr, int wc, int fr, int fq) const {
        asm volatile("" : "+v"(fr), "+v"(fq));
        unsigned char* ws = wsb; asm volatile("" : "+s"(ws));
        const float* ssq = (const float*)(ws + WS_SSQ); bf16_t* H = (bf16_t*)(ws + WS_H);
        const int hcol = u.pn * 128 + wc * 32 + 8 * fq;
#pragma unroll
        for (int ai = 0; ai < 2; ++ai)
#pragma unroll
            for (int m = 0; m < 4; ++m) {
                const int r = u.pm * 256 + ai * 128 + wr * 64 + m * 16 + fr;
                const float rs = row_rs(ssq, r);
                float hv[8];
#pragma unroll
                for (int n = 0; n < 2; ++n) {
                    const f32x4 g = acc[ai][0][m][n] * rs, up = acc[ai][1][m][n] * rs;
#pragma unroll
                    for (int e = 0; e < 4; ++e) hv[4 * n + e] = siluf_(g[e]) * up[e];
#ifdef DBG_HFILL
#pragma unroll
                    for (int e = 0; e < 4; ++e) hv[4 * n + e] = 0.01f * (float)((r + hcol + 4 * n + e) & 15);
#endif
                }
                u32x4 w; w.x = pk2(hv[0], hv[1]); w.y = pk2(hv[2], hv[3]); w.z = pk2(hv[4], hv[5]); w.w = pk2(hv[6], hv[7]);
                *(u32x4*)(H + (size_t)r * FFN + hcol) = w;
            }
    }
};

__device__ const double ROPE_INV[32] = {1.0, 0.7498942093324559, 0.5623413251903491, 0.4216965034285822, 0.31622776601683794, 0.23713737056616552, 0.1778279410038923,
    0.1333521432163324, 0.1, 0.07498942093324558, 0.05623413251903491, 0.042169650342858224, 0.03162277660168379, 0.023713737056616554, 0.01778279410038923,
    0.01333521432163324, 0.01, 0.007498942093324558, 0.005623413251903491, 0.004216965034285823, 0.0031622776601683794, 0.0023713737056616554, 0.0017782794100389228,
    0.001333521432163324, 0.001, 0.0007498942093324559, 0.0005623413251903491, 0.00042169650342858224, 0.00031622776601683794, 0.00023713737056616554,
    0.00017782794100389227, 0.0001333521432163324};

__device__ __forceinline__ int win_src(int j) {
    const int pn = j >> 8, rho = j & 255;
    if (pn < 2 || (pn == 2 && rho < 128)) {
        const int bj = rho >> 7, wc = (rho >> 5) & 3, n = (rho >> 4) & 1, fq = (rho >> 2) & 3, e = rho & 3;
        const int d = 16 * (wc & 1) + 4 * fq + e + 32 * n;
        if (pn < 2) return 64 * (4 * pn + 2 * bj + (wc >> 1)) + d;
        return 512 + 64 * (wc >> 1) + d;
    }
    if (pn == 2) return 640 + (rho - 128);
    if (pn == 3) return 768 + rho;
    if (pn == 4) return 1024 + rho;
    return 1280 + 256 * (pn - 5) + rho;
}
__device__ __forceinline__ int gu_hidden(int j) {
    const int pn = j >> 8, q = j & 127, wc = q >> 5, n = (q >> 4) & 1, fq = (q >> 2) & 3, e = q & 3;
    return 128 * pn + 32 * wc + 8 * fq + 4 * n + e;
}
template <int MODE>
__device__ __forceinline__ void cvt_load(const float* W, const float* W2, int Nsrc, const float* gain, LAS float* scr, int item, int njb, int lane) {
    const int kb = item / njb, jb = item % njb, k0 = 64 * kb, j0 = 32 * jb;
    const int jj = j0 + (lane & 31);
    int src; const float* Wp = W;
    if (MODE == 0) src = win_src(jj);
    else if (MODE == 1) src = jj;
    else { src = gu_hidden(jj); if ((jj >> 7) & 1) Wp = W2; }
#pragma unroll 8
    for (int i = 0; i < 32; ++i) {
        const int kk = 2 * i + (lane >> 5);
        float v = Wp[(size_t)(k0 + kk) * Nsrc + src];
        if (gain) v *= gain[k0 + kk];
        scr[kk * 33 + (lane & 31)] = v;
    }
}
__device__ __forceinline__ void cvt_store(int K, bf16_t* WT, const LAS float* scr, int item, int njb, int lane) {
    const int kb = item / njb, jb = item % njb, k0 = 64 * kb, j0 = 32 * jb;
    const int c = lane & 7;
#pragma unroll
    for (int q = 0; q < 4; ++q) {
        const int n = (lane >> 3) + 8 * q; const LAS float* s = scr + (8 * c) * 33 + n;
        u32x4 o; o.x = pk2(s[0 * 33], s[1 * 33]); o.y = pk2(s[2 * 33], s[3 * 33]); o.z = pk2(s[4 * 33], s[5 * 33]); o.w = pk2(s[6 * 33], s[7 * 33]);
        *(u32x4*)(WT + (size_t)(j0 + n) * K + k0 + 8 * c) = o;
    }
}

__device__ __forceinline__ void phase_prologue(const Params& P, LAS unsigned char* lds) {
    const int tid = launder_tid(), lane = tid & 63, wave = tid >> 6;
    const int gw = launder_bid() * 8 + wave, NGW = launder_gdim() * 8;
    const int gt = launder_bid() * 512 + tid, NGT = launder_gdim() * 512;
    unsigned char* ws = P.ws;
    LAS float* scr = (LAS float*)(lds + wave * 8448);
    constexpr int I_IN = 16 * 56, I_OUT = 16 * 32, I_GU = 16 * 176, I_DN = 44 * 32, I_L = I_IN + I_OUT + I_GU + I_DN;
    for (int it0 = launder_bid() * 8; it0 < NL * I_L; it0 += launder_gdim() * 8) {
        const int it = it0 + wave; const bool on = it < NL * I_L;
        const int l = it / I_L; int r = it % I_L; int kind = 0;
        if (r >= I_IN) { r -= I_IN; kind = 1; if (r >= I_OUT) { r -= I_OUT; kind = 2; if (r >= I_GU) { r -= I_GU; kind = 3; } } }
        if (on) {
            if (kind == 0) cvt_load<0>(P.in[I_WIN] + (size_t)l * DM * NINSRC, nullptr, NINSRC, P.in[I_LN1] + l * DM, scr, r, 56, lane);
            else if (kind == 1) cvt_load<1>(P.in[I_WOUT] + (size_t)l * DM * DM, nullptr, DM, nullptr, scr, r, 32, lane);
            else if (kind == 2) cvt_load<2>(P.in[I_WG] + (size_t)l * DM * FFN, P.in[I_WU] + (size_t)l * DM * FFN, FFN, P.in[I_LN2] + l * DM, scr, r, 176, lane);
            else cvt_load<1>(P.in[I_WD] + (size_t)l * FFN * DM, nullptr, DM, nullptr, scr, r, 32, lane);
        }
        LDS_WAIT(); __syncthreads();
        if (on) {
            if (kind == 0) cvt_store(DM, (bf16_t*)(ws + WS_WIN) + (size_t)l * NIN * DM, scr, r, 56, lane);
            else if (kind == 1) cvt_store(DM, (bf16_t*)(ws + WS_WOUT) + (size_t)l * DM * DM, scr, r, 32, lane);
            else if (kind == 2) cvt_store(DM, (bf16_t*)(ws + WS_WGU) + (size_t)l * NGU * DM, scr, r, 176, lane);
            else cvt_store(FFN, (bf16_t*)(ws + WS_WDN) + (size_t)l * DM * FFN, scr, r, 32, lane);
        }
        LDS_WAIT(); __syncthreads();
    }
    {
        float* XF = (float*)(ws + WS_XF); bf16_t* XB = (bf16_t*)(ws + WS_XB); float* ssq = (float*)(ws + WS_SSQ);
        for (int r = gw; r < MR; r += NGW) {
            const float* src = nullptr;
            if (r < R_META) src = P.in[I_XP] + (size_t)r * DM;
            else if (r < R_SAMP) src = P.in[I_META] + (size_t)((r - R_META) & 15) * DM;
            else if (r < R_VALID) src = P.in[I_XS] + (size_t)(r - R_SAMP) * DM;
            float s = 0.f;
#pragma unroll
            for (int j = 0; j < 4; ++j) {
                f32x4 v = {0.f, 0.f, 0.f, 0.f};
                if (src) v = *(const f32x4*)(src + 256 * j + 4 * lane);
                *(f32x4*)(XF + (size_t)r * DM + 256 * j + 4 * lane) = v;
                u32x2 w; w.x = pk2(v.x, v.y); w.y = pk2(v.z, v.w);
                *(u32x2*)(XB + (size_t)r * DM + 256 * j + 4 * lane) = w;
                s += (v.x * v.x + v.y * v.y) + (v.z * v.z + v.w * v.w);
            }
            s = wave_sum(s);
            if (lane < 4) ssq[(size_t)lane * MR + r] = lane == 0 ? s : 0.f;
        }
    }
    {
        bf16_t* MIX = (bf16_t*)(ws + WS_MIX);
        #ifdef DBG_RT
        for (int i = gt; i < MR * DM / 8; i += NGT) { u32x4 z = {0u, 0u, 0u, 0u}; *(u32x4*)(MIX + (size_t)i * 8) = z; }
#else
        for (int i = gt; i < (MR - R_VALID) * DM / 8; i += NGT) { u32x4 z = {0u, 0u, 0u, 0u}; *(u32x4*)(MIX + (size_t)R_VALID * DM + (size_t)i * 8) = z; }
#endif
    }
    {
        float* rc = (float*)(ws + TAB_ROPEC); float* rsn = (float*)(ws + TAB_ROPES);
        for (int i = gt; i < TT * 32; i += NGT) { const int pos = i >> 5, d = i & 31; float s, c; sincos_red((double)pos * ROPE_INV[d], s, c); rc[i] = c; rsn[i] = s; }
    }
    {
        float* ABAR = (float*)(ws + TAB_ABAR); float* A64 = (float*)(ws + TAB_A64); float* BBF = (float*)(ws + TAB_BBF);
        bf16_t* BBP = (bf16_t*)(ws + TAB_BBP); bf16_t* CC = (bf16_t*)(ws + TAB_CC);
        for (int i = gt; i < NL * 16 * 64; i += NGT) {
            const int l = i >> 10, g = (i >> 6) & 15, n = i & 63;
            const float dt = __expf(P.in[I_LOGDT][l * 16 + g]);
            const float ar = P.in[I_ARE][i], ai = P.in[I_AIM][i];
            const float mag = __expf(dt * ar);
            float sn, cs; sincos_red((double)dt * (double)ai, sn, cs);
            const float abr = mag * cs, abi = mag * sn;
            ABAR[2 * i] = abr; ABAR[2 * i + 1] = abi;
            const float mag64 = __expf(64.f * dt * ar);
            float s64, c64; sincos_red(64.0 * (double)dt * (double)ai, s64, c64);
            A64[2 * i] = mag64 * c64; A64[2 * i + 1] = mag64 * s64;
            const float den = ar * ar + ai * ai, xr = abr - 1.0f;
            const float fre = (xr * ar + abi * ai) / den, fim = (abi * ar - xr * ai) / den;
            const int gp = g >> 1, gi = g & 1;
            bf16_t* bp_re = BBP + (((size_t)l * 8 + gp) * 256 + 128 * gi + n) * 32;
            bf16_t* bp_im = bp_re + 64 * 32;
#pragma unroll
            for (int c = 0; c < 16; ++c) {
                const float br = P.in[I_BRE][(size_t)i * 16 + c], bi = P.in[I_BIM][(size_t)i * 16 + c];
                const float bbr = fre * br - fim * bi, bbi = fre * bi + fim * br;
                BBF[(size_t)i * 32 + c] = bbr; BBF[(size_t)i * 32 + 16 + c] = bbi;
                bp_re[16 * gi + c] = (bf16_t)f2bf(bbr); bp_im[16 * gi + c] = (bf16_t)f2bf(bbi);
                bp_re[16 * (1 - gi) + c] = 0; bp_im[16 * (1 - gi) + c] = 0;
            }
        }
        for (int i = gt; i < NL * 16 * 16 * 128; i += NGT) {
            const int k = i & 127, lgc = i >> 7;
            const float v = k < 64 ? P.in[I_CRE][(size_t)lgc * 64 + k] : -P.in[I_CIM][(size_t)lgc * 64 + (k - 64)];
            CC[i] = (bf16_t)f2bf(v);
        }
        bf16_t* GLUT = (bf16_t*)(ws + TAB_GLUT);
        for (int i = gt; i < NL * 256 * 256; i += NGT) {
            const int k = i & 255, n = (i >> 8) & 255, l = i >> 16;
            GLUT[i] = (bf16_t)f2bf(P.in[I_GLUW][((size_t)l * 256 + k) * 256 + n]);
        }
        float* WDT = (float*)(ws + TAB_WDT);
        for (int i = gt; i < NL * 4 * DM; i += NGT) {
            const int k = i & 1023, j = (i >> 10) & 3, l = i >> 12;
            WDT[i] = P.in[I_WIN][((size_t)l * DM + k) * NINSRC + NIN + j] * P.in[I_LN1][l * DM + k];
        }
    }
}

__device__ __forceinline__ void zero_pads(const Params& P, int l) {
    unsigned char* ws = P.ws;
    const int gt = launder_bid() * 512 + launder_tid(), NGT = launder_gdim() * 512;
    bf16_t* Kb = (bf16_t*)(ws + WS_K); bf16_t* Vt = (bf16_t*)(ws + WS_VT); float* U = (float*)(ws + ws_u_off(l)); bf16_t* XBCb = (bf16_t*)(ws + WS_XBC);
    for (int i = gt; i < 2 * 112 * 128; i += NGT) { const int c = i & 127, rr = i >> 7, b = rr / 112, lq = rr % 112, pr = b * BPAD + lq; Kb[(size_t)pr * 128 + c] = 0; Vt[(size_t)c * PR + pr] = 0; }
    for (int i = gt; i < 2 * 112 * 256; i += NGT) { const int c = i & 255, rr = i >> 8, b = rr / 112, lq = rr % 112, pr = b * BPAD + lq; U[(size_t)pr * 256 + c] = 0.f; }
    for (int i = gt; i < 2 * 112 * 512; i += NGT) { const int c = i & 511, rr = i >> 9, b = rr / 112, lq = rr % 112, pr = b * BPAD + lq; XBCb[(size_t)pr * 512 + c] = 0; }
}

__device__ __forceinline__ void dt_rows(const Params& P, int l) {
    const int lane = launder_tid() & 63, gw = launder_bid() * 8 + (launder_tid() >> 6), NGW = launder_gdim() * 8;
    const bf16_t* XB = (const bf16_t*)(P.ws + WS_XB); const float* ssq = (const float*)(P.ws + WS_SSQ);
    const float* WDT = (const float*)(P.ws + TAB_WDT) + (size_t)l * 4 * DM; float* DT = (float*)(P.ws + WS_DT);
    for (int r = gw; r < R_VALID; r += NGW) {
        int pos; const int pr = row_to_pr(r, pos);
        const u32x4 a = *(const u32x4*)(XB + (size_t)r * DM + 16 * lane), b = *(const u32x4*)(XB + (size_t)r * DM + 16 * lane + 8);
        float x[16] = {bflo(a.x), bfhi(a.x), bflo(a.y), bfhi(a.y), bflo(a.z), bfhi(a.z), bflo(a.w), bfhi(a.w),
                       bflo(b.x), bfhi(b.x), bflo(b.y), bfhi(b.y), bflo(b.z), bfhi(b.z), bflo(b.w), bfhi(b.w)};
        float d[4];
#pragma unroll
        for (int j = 0; j < 4; ++j) {
            const float* wv = WDT + j * DM + 16 * lane; float s = 0.f;
#pragma unroll
            for (int q = 0; q < 4; ++q) { const f32x4 w = *(const f32x4*)(wv + 4 * q); s += x[4 * q] * w.x + x[4 * q + 1] * w.y + x[4 * q + 2] * w.z + x[4 * q + 3] * w.w; }
            d[j] = wave_sum(s);
        }
        const float rs = row_rs(ssq, r);
        if (lane == 0) { f32x4 o = {d[0] * rs, d[1] * rs, d[2] * rs, d[3] * rs}; *(f32x4*)(DT + (size_t)pr * 4) = o; }
    }
}

__device__ __forceinline__ void attn_prompt_unit(const Params& P, int l, int b, int blk, LAS unsigned char* lds) {
    const int tid = launder_tid(), w = __builtin_amdgcn_readfirstlane(tid >> 6), lane = tid & 63, q = lane & 31, hh = lane >> 5;
    const int rt = w >> 1, kvh = w & 1;
    const int lq0 = blk * 128 + rt * 32, prq0 = b * BPAD + lq0;
    const bf16_t* Q = (const bf16_t*)(P.ws + WS_Q); const bf16_t* Kb = (const bf16_t*)(P.ws + WS_K); const bf16_t* Vt = (const bf16_t*)(P.ws + WS_VT);
    LAS bf16_t* ob = (LAS bf16_t*)(lds + w * 16896);
    LAS float* ssx = (LAS float*)(lds + 8 * 16896);
    float ssq_acc = 0.f;
    const int tq = lq0 + q - 112;
    for (int hq = 0; hq < 4; ++hq) {
        const int head = kvh * 4 + hq;
        bf16x8 qf[4];
#pragma unroll
        for (int ks = 0; ks < 4; ++ks) qf[ks] = *(const bf16x8*)(Q + (size_t)(prq0 + q) * 512 + head * 64 + ks * 16 + hh * 8);
        f32x16 S[5];
#pragma unroll
        for (int kt = 0; kt < 5; ++kt) {
            int prk = prq0 - 128 + kt * 32 + q; prk = prk < 0 ? 0 : prk;
            f32x16 a;
#pragma unroll
            for (int e = 0; e < 16; ++e) a[e] = 0.f;
#pragma unroll
            for (int ks = 0; ks < 4; ++ks) { const bf16x8 kf = *(const bf16x8*)(Kb + (size_t)prk * 128 + kvh * 64 + ks * 16 + hh * 8); a = MFMA32(kf, qf[ks], a); }
            S[kt] = a;
            asm volatile("" ::: "memory");
        }
        float mx = -INFINITY;
#pragma unroll
        for (int kt = 0; kt < 5; ++kt)
#pragma unroll
            for (int e = 0; e < 16; ++e) {
                const int tk = lq0 - 128 + kt * 32 + (e & 3) + 8 * (e >> 2) + 4 * hh - 112;
                const bool ok = (tk >= 0) && (tk <= tq) && (tq - tk <= 128);
                const float s = ok ? S[kt][e] * 0.125f : -INFINITY;
                S[kt][e] = s; mx = fmaxf(mx, s);
            }
        mx = fmaxf(mx, __shfl_xor(mx, 32));
        const float sink = P.in[I_SINK][l * 8 + head];
        const float mfin = fmaxf(mx, sink);
        float sum = 0.f;
#pragma unroll
        for (int kt = 0; kt < 5; ++kt)
#pragma unroll
            for (int e = 0; e < 16; ++e) { const float p = __expf(S[kt][e] - mfin); S[kt][e] = p; sum += p; }
        sum += __shfl_xor(sum, 32);
        const float inv = 1.0f / (sum + __expf(sink - mfin));
        f32x16 O0, O1;
#pragma unroll
        for (int e = 0; e < 16; ++e) { O0[e] = 0.f; O1[e] = 0.f; }
#pragma unroll
        for (int kt = 0; kt < 5; ++kt)
#pragma unroll
            for (int s2 = 0; s2 < 2; ++s2) {
                u32x4 pw; pw.x = pk2(S[kt][8 * s2 + 0], S[kt][8 * s2 + 1]); pw.y = pk2(S[kt][8 * s2 + 2], S[kt][8 * s2 + 3]);
                pw.z = pk2(S[kt][8 * s2 + 4], S[kt][8 * s2 + 5]); pw.w = pk2(S[kt][8 * s2 + 6], S[kt][8 * s2 + 7]);
                const bf16x8 pf = __builtin_bit_cast(bf16x8, pw);
                int k0 = prq0 - 128 + kt * 32 + 16 * s2 + 4 * hh, k1 = k0 + 8;
                k0 = k0 < 0 ? 0 : k0; k1 = k1 < 0 ? 0 : k1;
                const bf16_t* v0 = Vt + (size_t)(kvh * 64 + q) * PR;
                const bf16_t* v1 = Vt + (size_t)(kvh * 64 + 32 + q) * PR;
                u32x4 a0, a1; const u32x2 x0 = *(const u32x2*)(v0 + k0), x1 = *(const u32x2*)(v0 + k1), y0 = *(const u32x2*)(v1 + k0), y1 = *(const u32x2*)(v1 + k1);
                a0.x = x0.x; a0.y = x0.y; a0.z = x1.x; a0.w = x1.y; a1.x = y0.x; a1.y = y0.y; a1.z = y1.x; a1.w = y1.y;
                O0 = MFMA32(__builtin_bit_cast(bf16x8, a0), pf, O0);
                O1 = MFMA32(__builtin_bit_cast(bf16x8, a1), pf, O1);
                asm volatile("" ::: "memory");
            }
        float qs = 0.f;
#pragma unroll
        for (int e = 0; e < 16; ++e) { O0[e] *= inv; O1[e] *= inv; qs += O0[e] * O0[e] + O1[e] * O1[e]; }
        qs += __shfl_xor(qs, 32);
        ssq_acc += qs;
#pragma unroll
        for (int g4 = 0; g4 < 4; ++g4) {
            u32x2 w0, w1; w0.x = pk2(O0[4 * g4], O0[4 * g4 + 1]); w0.y = pk2(O0[4 * g4 + 2], O0[4 * g4 + 3]); w1.x = pk2(O1[4 * g4], O1[4 * g4 + 1]); w1.y = pk2(O1[4 * g4 + 2], O1[4 * g4 + 3]);
            *(LAS u32x2*)(ob + q * 264 + hq * 64 + 8 * g4 + 4 * hh) = w0;
            *(LAS u32x2*)(ob + q * 264 + hq * 64 + 32 + 8 * g4 + 4 * hh) = w1;
        }
    }
    if (hh == 0) ssx[(rt * 2 + kvh) * 32 + q] = ssq_acc;
    LDS_WAIT(); __syncthreads();
    bf16_t* MIX = (bf16_t*)(P.ws + WS_MIX); const float* gain = P.in[I_ATTG] + l * 512 + kvh * 256;
#pragma unroll 4
    for (int it = 0; it < 16; ++it) {
        const int chunk = it * 64 + lane, row = chunk >> 5, cc = chunk & 31;
        const int r = pr_to_row(prq0 + row);
        const float tot = ssx[(rt * 2) * 32 + row] + ssx[(rt * 2 + 1) * 32 + row];
        const float rs = rsqrtf(tot * (1.0f / 512.0f) + EPS);
        const u32x4 v = *(const LAS u32x4*)(ob + row * 264 + cc * 8);
        const f32x4 g0 = *(const f32x4*)(gain + cc * 8), g1 = *(const f32x4*)(gain + cc * 8 + 4);
        u32x4 o; o.x = pk2(bflo(v.x) * rs * g0.x, bfhi(v.x) * rs * g0.y); o.y = pk2(bflo(v.y) * rs * g0.z, bfhi(v.y) * rs * g0.w);
        o.z = pk2(bflo(v.z) * rs * g1.x, bfhi(v.z) * rs * g1.y); o.w = pk2(bflo(v.w) * rs * g1.z, bfhi(v.w) * rs * g1.w);
        if (r >= 0) *(u32x4*)(MIX + (size_t)r * DM + kvh * 256 + cc * 8) = o;
    }
    __syncthreads();
}

__device__ __forceinline__ void attn_sample_unit(const Params& P, int l, int i, LAS unsigned char* lds) {
    const int tid = launder_tid(), w = __builtin_amdgcn_readfirstlane(tid >> 6), lane = tid & 63, kvh = w >> 2;
    const int pr = PR_SAMP + i;
    const bf16_t* Q = (const bf16_t*)(P.ws + WS_Q) + (size_t)pr * 512 + w * 64;
    float qv[64];
#pragma unroll
    for (int c = 0; c < 8; ++c) { const u32x4 v = *(const u32x4*)(Q + 8 * c); qv[8 * c] = bflo(v.x); qv[8 * c + 1] = bfhi(v.x); qv[8 * c + 2] = bflo(v.y); qv[8 * c + 3] = bfhi(v.y);
        qv[8 * c + 4] = bflo(v.z); qv[8 * c + 5] = bfhi(v.z); qv[8 * c + 6] = bflo(v.w); qv[8 * c + 7] = bfhi(v.w); }
    const float* ck = P.in[I_CK] + (((size_t)l * 128 + i) * 128) * 128 + kvh * 64;
    const float* cv = P.in[I_CV] + (((size_t)l * 128 + i) * 128) * 128 + kvh * 64;
    float s0 = 0.f, s1 = 0.f, sn = 0.f;
#pragma unroll
    for (int c = 0; c < 16; ++c) {
        const f32x4 a = *(const f32x4*)(ck + (size_t)lane * 128 + 4 * c), b2 = *(const f32x4*)(ck + (size_t)(lane + 64) * 128 + 4 * c);
        s0 += qv[4 * c] * a.x + qv[4 * c + 1] * a.y + qv[4 * c + 2] * a.z + qv[4 * c + 3] * a.w;
        s1 += qv[4 * c] * b2.x + qv[4 * c + 1] * b2.y + qv[4 * c + 2] * b2.z + qv[4 * c + 3] * b2.w;
    }
    {
        const bf16_t* kn = (const bf16_t*)(P.ws + WS_K) + (size_t)pr * 128 + kvh * 64;
#pragma unroll
        for (int c = 0; c < 8; ++c) { const u32x4 v = *(const u32x4*)(kn + 8 * c);
            sn += qv[8 * c] * bflo(v.x) + qv[8 * c + 1] * bfhi(v.x) + qv[8 * c + 2] * bflo(v.y) + qv[8 * c + 3] * bfhi(v.y) + qv[8 * c + 4] * bflo(v.z) + qv[8 * c + 5] * bfhi(v.z) + qv[8 * c + 6] * bflo(v.w) + qv[8 * c + 7] * bfhi(v.w); }
    }
    s0 *= 0.125f; s1 *= 0.125f; sn *= 0.125f;
    const float sink = P.in[I_SINK][l * 8 + w];
    const float m = fmaxf(wave_max(fmaxf(fmaxf(s0, s1), sn)), sink);
    const float p0 = __expf(s0 - m), p1 = __expf(s1 - m), pn = __expf(sn - m);
    const float den = wave_sum(p0 + p1) + pn + __expf(sink - m);
    float o = 0.f;
#pragma unroll 16
    for (int j = 0; j < 64; ++j) { const float pj = __shfl(p0, j); o += pj * cv[(size_t)j * 128 + lane]; }
#pragma unroll 16
    for (int j = 0; j < 64; ++j) { const float pj = __shfl(p1, j); o += pj * cv[(size_t)(j + 64) * 128 + lane]; }
    const bf16_t* Vt = (const bf16_t*)(P.ws + WS_VT);
    o += pn * bf2f(Vt[(size_t)(kvh * 64 + lane) * PR + pr]);
    o /= den;
    LAS float* ssx = (LAS float*)lds;
    const float qs = wave_sum(o * o);
    if (lane == 0) ssx[w] = qs;
    LDS_WAIT(); __syncthreads();
    float tot = 0.f;
#pragma unroll
    for (int k = 0; k < 8; ++k) tot += ssx[k];
    const float rs = rsqrtf(tot * (1.0f / 512.0f) + EPS);
    bf16_t* MIX = (bf16_t*)(P.ws + WS_MIX);
    MIX[(size_t)(R_SAMP + i) * DM + w * 64 + lane] = (bf16_t)f2bf(o * rs * P.in[I_ATTG][l * 512 + w * 64 + lane]);
    const float* cks = P.in[I_CK] + (((size_t)l * 128 + i) * 128 + 1) * 128; const float* cvs = P.in[I_CV] + (((size_t)l * 128 + i) * 128 + 1) * 128;
    float* oks = P.out + O_KS + (((size_t)l * 128 + i) * 128) * 128; float* ovs = P.out + O_VS + (((size_t)l * 128 + i) * 128) * 128;
    for (int x = tid; x < 127 * 32; x += 512) { *(f32x4*)(oks + 4 * x) = *(const f32x4*)(cks + 4 * x); *(f32x4*)(ovs + 4 * x) = *(const f32x4*)(cvs + 4 * x); }
    __syncthreads();
}

#define S5_EXTRA_SYNC() __syncthreads()
template <bool OUT>
__device__ __forceinline__ void s5_unit(const Params& P, int l, int b, int c, LAS unsigned char* lds) {
    const int tid = launder_tid(), w = __builtin_amdgcn_readfirstlane(tid >> 6), lane = tid & 63, fr = lane & 15, fq = lane >> 4;
    const int pr0 = b * BPAD + 64 * c;
    LAS float* bu = (LAS float*)(lds + w * 12800);
    LAS bf16_t* hb = (LAS bf16_t*)(lds + w * 12800 + 8448);
    LAS bf16_t* y5 = (LAS bf16_t*)(lds + 102400);
    LAS float* ssx = (LAS float*)(lds + 102400 + 33792);
    const float* U = (const float*)(P.ws + ws_u_off(l));
    const bf16_t* BBP = (const bf16_t*)(P.ws + TAB_BBP); const bf16_t* CC = (const bf16_t*)(P.ws + TAB_CC);
    const float* ABAR = (const float*)(P.ws + TAB_ABAR);
    for (int gi = 0; gi < 2; ++gi) {
        const int g = 2 * w + gi;
        bf16x8 bbf[8];
#pragma unroll
        for (int nt = 0; nt < 8; ++nt) bbf[nt] = *(const bf16x8*)(BBP + (((size_t)l * 8 + w) * 256 + 128 * gi + 16 * nt + fr) * 32 + 8 * fq);
        bf16x8 ccf[4];
        if (OUT) {
#pragma unroll
            for (int ks = 0; ks < 4; ++ks) ccf[ks] = *(const bf16x8*)(CC + (((size_t)l * 16 + g) * 16 + fr) * 128 + 32 * ks + 8 * fq);
        }
        const size_t sidx = (((size_t)l * 16 + g) * 64 + lane) * 2;
        const float ar = ABAR[sidx], ai = ABAR[sidx + 1];
        const size_t eidx = ((((size_t)b * NCH5 + c) * 16 + g) * 64 + lane) * 2;
        float hr = 0.f, hi = 0.f;
#ifndef DBG_S5C
        if (OUT) { float* H0 = (float*)(P.ws + WS_H05);
#ifdef DBG_S5D
            hr = __hip_atomic_load(H0 + eidx, __ATOMIC_RELAXED, __HIP_MEMORY_SCOPE_AGENT); hi = __hip_atomic_load(H0 + eidx + 1, __ATOMIC_RELAXED, __HIP_MEMORY_SCOPE_AGENT);
#else
            hr = H0[eidx]; hi = H0[eidx + 1];
#endif
        }
#endif
        const float dd = OUT ? P.in[I_S5D][l * 256 + 16 * g + fr] : 0.f;
        for (int sb = 0; sb < 4; ++sb) {
            const bf16x8 uf = ld_bf16x8_f32(U + (size_t)(pr0 + 16 * sb + fr) * 256 + 32 * w + 8 * fq);
#pragma unroll
            for (int nt = 0; nt < 8; ++nt) {
                f32x4 z = {0.f, 0.f, 0.f, 0.f};
                f32x4 d = MFMA16(uf, bbf[nt], z);
#pragma unroll
                for (int e = 0; e < 4; ++e) bu[(4 * fq + e) * 132 + 16 * nt + fr] = d[e];
            }
            LDS_WAIT(); asm volatile("" ::: "memory"); S5_EXTRA_SYNC();
#pragma unroll
            for (int tok = 0; tok < 16; ++tok) {
                const float bre = bu[tok * 132 + lane], bim = bu[tok * 132 + 64 + lane];
                const float nr = ar * hr - ai * hi + bre, ni = ar * hi + ai * hr + bim;
                hr = nr; hi = ni;
                if (OUT) { hb[tok * 136 + lane] = (bf16_t)f2bf(hr); hb[tok * 136 + 64 + lane] = (bf16_t)f2bf(hi); }
            }
            LDS_WAIT(); asm volatile("" ::: "memory"); S5_EXTRA_SYNC();
            if (OUT) {
                f32x4 y = {0.f, 0.f, 0.f, 0.f};
#pragma unroll
                for (int ks = 0; ks < 4; ++ks) { const bf16x8 hf = *(const LAS bf16x8*)(hb + fr * 136 + 32 * ks + 8 * fq); y = MFMA16(hf, ccf[ks], y); }

#pragma unroll
                for (int e = 0; e < 4; ++e) {
                    const int tok = 16 * sb + 4 * fq + e;
                    const float uu = U[(size_t)(pr0 + tok) * 256 + 16 * g + fr];
#ifdef DBG_S5A
                    y5[tok * 264 + 16 * g + fr] = (bf16_t)f2bf(gelu_tanh(0.f * y[e] + dd * uu));
#else
                    y5[tok * 264 + 16 * g + fr] = (bf16_t)f2bf(gelu_tanh(y[e] + dd * uu));
#endif
                }
                LDS_WAIT(); asm volatile("" ::: "memory"); S5_EXTRA_SYNC();
            }
        }
        if (!OUT) { float* E5 = (float*)(P.ws + ws_e5_off(l));
#ifdef DBG_S5D
            __hip_atomic_store(E5 + eidx, hr, __ATOMIC_RELAXED, __HIP_MEMORY_SCOPE_AGENT); __hip_atomic_store(E5 + eidx + 1, hi, __ATOMIC_RELAXED, __HIP_MEMORY_SCOPE_AGENT);
#else
            E5[eidx] = hr; E5[eidx + 1] = hi;
#endif
        }
    }
    if (!OUT) { __syncthreads(); return; }
    __syncthreads();
    const bf16_t* GLUT = (const bf16_t*)(P.ws + TAB_GLUT) + (size_t)l * 65536;
    f32x4 ga[4][2];
#pragma unroll
    for (int mt = 0; mt < 4; ++mt)
#pragma unroll
        for (int j = 0; j < 2; ++j) ga[mt][j] = (f32x4){0.f, 0.f, 0.f, 0.f};
#pragma unroll 2
    for (int ks = 0; ks < 8; ++ks) {
        bf16x8 bfr[2];
#pragma unroll
        for (int j = 0; j < 2; ++j) bfr[j] = *(const bf16x8*)(GLUT + (size_t)(32 * w + 16 * j + fr) * 256 + 32 * ks + 8 * fq);
#pragma unroll
        for (int mt = 0; mt < 4; ++mt) {
            const bf16x8 af = *(const LAS bf16x8*)(y5 + (16 * mt + fr) * 264 + 32 * ks + 8 * fq);
#pragma unroll
            for (int j = 0; j < 2; ++j) ga[mt][j] = MFMA16(af, bfr[j], ga[mt][j]);
        }
    }
#pragma unroll
    for (int mt = 0; mt < 4; ++mt) {
        float part[4] = {0.f, 0.f, 0.f, 0.f};
#pragma unroll
        for (int j = 0; j < 2; ++j) {
            const int n = 32 * w + 16 * j + fr; const float gb = P.in[I_GLUB][l * 256 + n];
#pragma unroll
            for (int e = 0; e < 4; ++e) {
                const int tok = 16 * mt + 4 * fq + e;
#ifdef DBG_S5B
                const float v = bf2f(y5[tok * 264 + n]) * sigmoidf_(0.f * ga[mt][j][e] + gb);
#else
                const float v = bf2f(y5[tok * 264 + n]) * sigmoidf_(ga[mt][j][e] + gb);
#endif
                ga[mt][j][e] = v; part[e] += v * v;
            }
        }
#pragma unroll
        for (int e = 0; e < 4; ++e) {
            float p = part[e]; p += __shfl_xor(p, 1); p += __shfl_xor(p, 2); p += __shfl_xor(p, 4); p += __shfl_xor(p, 8);
            if (fr == 0) ssx[(16 * mt + 4 * fq + e) * 8 + w] = p;
        }
    }
    LDS_WAIT(); __syncthreads();
#pragma unroll
    for (int mt = 0; mt < 4; ++mt)
#pragma unroll
        for (int j = 0; j < 2; ++j)
#pragma unroll
            for (int e = 0; e < 4; ++e) y5[(16 * mt + 4 * fq + e) * 264 + 32 * w + 16 * j + fr] = (bf16_t)f2bf(ga[mt][j][e]);
    LDS_WAIT(); __syncthreads();
    bf16_t* MIX = (bf16_t*)(P.ws + WS_MIX); const float* gain = P.in[I_S5G] + l * 256;
#pragma unroll
    for (int it = 0; it < 4; ++it) {
        const int chunk = it * 512 + tid, row = chunk >> 5, cc = chunk & 31;
        const int r = pr_to_row(pr0 + row);
        const f32x4 t0 = *(const LAS f32x4*)(ssx + row * 8), t1 = *(const LAS f32x4*)(ssx + row * 8 + 4);
        const float tot = ((t0.x + t0.y) + (t0.z + t0.w)) + ((t1.x + t1.y) + (t1.z + t1.w));
        const float rs = rsqrtf(tot * (1.0f / 256.0f) + EPS);
        const u32x4 v = *(const LAS u32x4*)(y5 + row * 264 + cc * 8);
        const f32x4 g0 = *(const f32x4*)(gain + cc * 8), g1 = *(const f32x4*)(gain + cc * 8 + 4);
        u32x4 o; o.x = pk2(bflo(v.x) * rs * g0.x, bfhi(v.x) * rs * g0.y); o.y = pk2(bflo(v.y) * rs * g0.z, bfhi(v.y) * rs * g0.w);
        o.z = pk2(bflo(v.z) * rs * g1.x, bfhi(v.z) * rs * g1.y); o.w = pk2(bflo(v.w) * rs * g1.z, bfhi(v.w) * rs * g1.w);
        if (r >= 0) *(u32x4*)(MIX + (size_t)r * DM + 512 + cc * 8) = o;
    }
    __syncthreads();
}

__device__ __forceinline__ void s5_sample_unit(const Params& P, int l, int i, LAS unsigned char* lds) {
    const int tid = launder_tid(), pr = PR_SAMP + i;
    LAS float* hsr = (LAS float*)lds;
    LAS float* hsi = hsr + 1024;
    LAS float* us = hsi + 1024;
    LAS float* ys = us + 256;
    LAS float* red = ys + 256;
    const float* U = (const float*)(P.ws + ws_u_off(l)) + (size_t)pr * 256;
    if (tid < 256) us[tid] = U[tid];
    LDS_WAIT(); __syncthreads();
    const float* ABAR = (const float*)(P.ws + TAB_ABAR); const float* BBF = (const float*)(P.ws + TAB_BBF);
#pragma unroll
    for (int rep = 0; rep < 2; ++rep) {
        const int idx = tid + 512 * rep, g = idx >> 6;
        const size_t si = (size_t)l * 1024 + idx;
        const float ar = ABAR[2 * si], ai = ABAR[2 * si + 1];
        const size_t st = ((size_t)l * 128 + i) * 1024 + idx;
        const float h0r = P.in[I_S5R][st], h0i = P.in[I_S5I][st];
        float br = 0.f, bi = 0.f;
#pragma unroll
        for (int cch = 0; cch < 16; ++cch) { const float uu = us[16 * g + cch]; br += BBF[si * 32 + cch] * uu; bi += BBF[si * 32 + 16 + cch] * uu; }
        const float hr = ar * h0r - ai * h0i + br, hi = ar * h0i + ai * h0r + bi;
        P.out[O_S5RS + st] = hr; P.out[O_S5IS + st] = hi;
        hsr[idx] = hr; hsi[idx] = hi;
    }
    LDS_WAIT(); __syncthreads();
    if (tid < 256) {
        const int g = tid >> 4;
        const float* cr = P.in[I_CRE] + ((size_t)l * 256 + tid) * 64; const float* ci = P.in[I_CIM] + ((size_t)l * 256 + tid) * 64;
        float y = 0.f;
#pragma unroll 8
        for (int n = 0; n < 64; ++n) y += cr[n] * hsr[64 * g + n] - ci[n] * hsi[64 * g + n];
        y += P.in[I_S5D][l * 256 + tid] * us[tid];
        ys[tid] = gelu_tanh(y);
    }
    LDS_WAIT(); __syncthreads();
    float v = 0.f;
    if (tid < 256) {
        const float* gw = P.in[I_GLUW] + (size_t)l * 65536 + tid; float z = P.in[I_GLUB][l * 256 + tid];
#pragma unroll 8
        for (int k = 0; k < 256; ++k) z += ys[k] * gw[(size_t)k * 256];
        v = ys[tid] * sigmoidf_(z);
    }
    const float qs = wave_sum(v * v);
    if ((tid & 63) == 0) red[tid >> 6] = qs;
    LDS_WAIT(); __syncthreads();
    const float tot = (red[0] + red[1]) + (red[2] + red[3]);
    const float rs = rsqrtf(tot * (1.0f / 256.0f) + EPS);
    if (tid < 256) ((bf16_t*)(P.ws + WS_MIX))[(size_t)(R_SAMP + i) * DM + 512 + tid] = (bf16_t)f2bf(v * rs * P.in[I_S5G][l * 256 + tid]);
    __syncthreads();
}

__device__ __forceinline__ void ssd_local_unit(const Params& P, int l, int b, int c, LAS unsigned char* lds) {
    const int tid = launder_tid(), w = __builtin_amdgcn_readfirstlane(tid >> 6), lane = tid & 63, fr = lane & 15, fq = lane >> 4;
    const int pr0 = b * BPAD + 128 * c;
    LAS bf16_t* xwT = (LAS bf16_t*)lds;
    LAS bf16_t* bmT = (LAS bf16_t*)(lds + 69632);
    LAS float* dts = (LAS float*)(lds + 104448);
    LAS float* cs = (LAS float*)(lds + 106496);
    {
        const int j = tid >> 2, h = tid & 3, t = 128 * c + j - 112;
        float v = 0.f;
        if (t >= 0) v = softplusf_(((const float*)(P.ws + WS_DT))[(size_t)(pr0 + j) * 4 + h] + P.in[I_DTB][l * 4 + h]);
        dts[tid] = v; ((float*)(P.ws + WS_DTS))[(size_t)pr0 * 4 + tid] = v;
    }
    LDS_WAIT(); __syncthreads();
    if (w < 4) {
        const int h = w; const float A = -__expf(P.in[I_ALOG][l * 4 + h]);
        const float a0 = dts[(2 * lane) * 4 + h] * A, a1 = dts[(2 * lane + 1) * 4 + h] * A;
        float s = a0 + a1;
#pragma unroll
        for (int off = 1; off < 64; off <<= 1) { const float v = __shfl_up(s, off); if (lane >= off) s += v; }
        cs[(2 * lane + 1) * 4 + h] = s; cs[(2 * lane) * 4 + h] = s - a1;
        float* CS = (float*)(P.ws + WS_CS) + (size_t)pr0 * 4;
        CS[(2 * lane + 1) * 4 + h] = s; CS[(2 * lane) * 4 + h] = s - a1;
    }
    LDS_WAIT(); __syncthreads();
    {
        const int ch = tid, h = (ch >> 6) & 3;
        const float w0 = P.in[I_CONVW][(l * 4 + 0) * 512 + ch], w1 = P.in[I_CONVW][(l * 4 + 1) * 512 + ch], w2 = P.in[I_CONVW][(l * 4 + 2) * 512 + ch], w3 = P.in[I_CONVW][(l * 4 + 3) * 512 + ch];
        const float bias = P.in[I_CONVB][l * 512 + ch];
        const bf16_t* XBCb = (const bf16_t*)(P.ws + WS_XBC); bf16_t* XC = (bf16_t*)(P.ws + WS_XC);
        float x0 = 0.f, x1 = 0.f, x2 = 0.f;
        if (c > 0) { x0 = bf2f(XBCb[(size_t)(pr0 - 3) * 512 + ch]); x1 = bf2f(XBCb[(size_t)(pr0 - 2) * 512 + ch]); x2 = bf2f(XBCb[(size_t)(pr0 - 1) * 512 + ch]); }
        const float cl = cs[127 * 4 + h];
#pragma unroll 4
        for (int j = 0; j < 128; ++j) {
            const float xn = bf2f(XBCb[(size_t)(pr0 + j) * 512 + ch]);
            const float v = bias + w0 * x0 + w1 * x1 + w2 * x2 + w3 * xn;
            x0 = x1; x1 = x2; x2 = xn;
            const float xc = (128 * c + j - 112 >= 0) ? siluf_(v) : 0.f;
            XC[(size_t)(pr0 + j) * 512 + ch] = (bf16_t)f2bf(xc);
            if (ch < 256) { const float sc = dts[j * 4 + h] * __expf(cl - cs[j * 4 + h]); xwT[ch * 136 + j] = (bf16_t)f2bf(xc * sc); }
            else if (ch < 384) bmT[(ch - 256) * 136 + j] = (bf16_t)f2bf(xc);
        }
    }
    LDS_WAIT(); __syncthreads();
    {
        const int h = w >> 1, pt0 = 2 * (w & 1), g = h >> 1;
        f32x4 acc[2][4];
#pragma unroll
        for (int a = 0; a < 2; ++a)
#pragma unroll
            for (int nt = 0; nt < 4; ++nt) acc[a][nt] = (f32x4){0.f, 0.f, 0.f, 0.f};
#pragma unroll
        for (int ks = 0; ks < 4; ++ks) {
            bf16x8 af[2], bfr[4];
#pragma unroll
            for (int a = 0; a < 2; ++a) af[a] = *(const LAS bf16x8*)(xwT + (64 * h + 16 * (pt0 + a) + fr) * 136 + 32 * ks + 8 * fq);
#pragma unroll
            for (int nt = 0; nt < 4; ++nt) bfr[nt] = *(const LAS bf16x8*)(bmT + (64 * g + 16 * nt + fr) * 136 + 32 * ks + 8 * fq);
#pragma unroll
            for (int a = 0; a < 2; ++a)
#pragma unroll
                for (int nt = 0; nt < 4; ++nt) acc[a][nt] = MFMA16(af[a], bfr[nt], acc[a][nt]);
        }
        float* S = (float*)(P.ws + WS_SLOC) + ((size_t)((b * NCH + c) * 4 + h)) * 4096;
#pragma unroll
        for (int a = 0; a < 2; ++a)
#pragma unroll
            for (int nt = 0; nt < 4; ++nt)
#pragma unroll
                for (int e = 0; e < 4; ++e) S[(16 * (pt0 + a) + 4 * fq + e) * 64 + 16 * nt + fr] = acc[a][nt][e];
        if (tid < 4) ((float*)(P.ws + WS_CD))[(b * NCH + c) * 4 + tid] = __expf(cs[127 * 4 + tid]);
    }
    __syncthreads();
}

__device__ __forceinline__ void carry_phase(const Params& P, int l) {
    const int T = launder_bid() * 512 + launder_tid();
    if (T < 2048) {
        const int b = T >> 10, gn = T & 1023;
        const float* A64 = (const float*)(P.ws + TAB_A64) + ((size_t)l * 1024 + gn) * 2;
        const float ar = A64[0], ai = A64[1];
        const float* E5 = (const float*)(P.ws + ws_e5_off(l)); float* H0 = (float*)(P.ws + WS_H05);
        float hr = 0.f, hi = 0.f;
#pragma unroll 10
        for (int c = 0; c < NCH5; ++c) {
            const size_t idx = (((size_t)b * NCH5 + c) * 1024 + gn) * 2;
#ifdef DBG_S5D
            const float er = __hip_atomic_load((float*)E5 + idx, __ATOMIC_RELAXED, __HIP_MEMORY_SCOPE_AGENT), ei = __hip_atomic_load((float*)E5 + idx + 1, __ATOMIC_RELAXED, __HIP_MEMORY_SCOPE_AGENT);
#else
            const float er = E5[idx], ei = E5[idx + 1];
#endif
            H0[idx] = hr; H0[idx + 1] = hi;
#ifdef DBG_S5E
            const float nr = ar * hr - ai * hi + 0.01f + 0.f * er, ni = ar * hi + ai * hr + 0.02f + 0.f * ei;
#else
            const float nr = ar * hr - ai * hi + er, ni = ar * hi + ai * hr + ei;
#endif
            hr = nr; hi = ni;
        }
        P.out[O_S5RP + ((size_t)l * 2 + b) * 1024 + gn] = hr; P.out[O_S5IP + ((size_t)l * 2 + b) * 1024 + gn] = hi;
    } else if (T < 2048 + 32768) {
        const int gid = T - 2048, b = gid >> 14, h = (gid >> 12) & 3, e = gid & 4095;
        const float* S = (const float*)(P.ws + WS_SLOC); float* HP = (float*)(P.ws + WS_HP); const float* CD = (const float*)(P.ws + WS_CD);
        float hs = 0.f;
#pragma unroll 13
        for (int c = 0; c < NCH; ++c) {
            const size_t idx = ((size_t)((b * NCH + c) * 4 + h)) * 4096 + e;
            const float s = S[idx], cd = CD[(b * NCH + c) * 4 + h];
            HP[idx] = hs;
            hs = cd * hs + s;
        }
        P.out[O_SSDP + ((size_t)(l * 2 + b) * 4 + h) * 4096 + e] = hs;
    }
}

__device__ __forceinline__ void ssd_out_unit(const Params& P, int l, int b, int c, LAS unsigned char* lds) {
    const int tid = launder_tid(), w = __builtin_amdgcn_readfirstlane(tid >> 6), lane = tid & 63, fr = lane & 15, fq = lane >> 4;
    const int pr0 = b * BPAD + 128 * c;
    LAS bf16_t* xsT = (LAS bf16_t*)lds;
    LAS bf16_t* scw = (LAS bf16_t*)(lds + 69632 + w * 4352);
    LAS float* cs = (LAS float*)(lds + 104448);
    LAS float* dts = (LAS float*)(lds + 106496);
    LAS float* ssq4 = (LAS float*)(lds + 108544);
    const bf16_t* XC = (const bf16_t*)(P.ws + WS_XC);
#pragma unroll
    for (int it = 0; it < 8; ++it) {
        const int chunk = it * 512 + tid, j = chunk >> 5, c8 = (chunk & 31) * 8;
        const u32x4 v = *(const u32x4*)(XC + (size_t)(pr0 + j) * 512 + c8);
        xsT[(c8 + 0) * 136 + j] = (bf16_t)(v.x & 0xffff); xsT[(c8 + 1) * 136 + j] = (bf16_t)(v.x >> 16);
        xsT[(c8 + 2) * 136 + j] = (bf16_t)(v.y & 0xffff); xsT[(c8 + 3) * 136 + j] = (bf16_t)(v.y >> 16);
        xsT[(c8 + 4) * 136 + j] = (bf16_t)(v.z & 0xffff); xsT[(c8 + 5) * 136 + j] = (bf16_t)(v.z >> 16);
        xsT[(c8 + 6) * 136 + j] = (bf16_t)(v.w & 0xffff); xsT[(c8 + 7) * 136 + j] = (bf16_t)(v.w >> 16);
    }
    cs[tid] = ((const float*)(P.ws + WS_CS))[(size_t)pr0 * 4 + tid];
    dts[tid] = ((const float*)(P.ws + WS_DTS))[(size_t)pr0 * 4 + tid];
    LDS_WAIT(); __syncthreads();
    const int h = w >> 1, half = w & 1, g = h >> 1;
    const float* hp = (const float*)(P.ws + WS_HP) + ((size_t)((b * NCH + c) * 4 + h)) * 4096;
    bf16x8 hpf[4][2];
#pragma unroll
    for (int pt = 0; pt < 4; ++pt)
#pragma unroll
        for (int ks = 0; ks < 2; ++ks) hpf[pt][ks] = ld_bf16x8_f32(hp + (16 * pt + fr) * 64 + 32 * ks + 8 * fq);
    const float Dh = P.in[I_SSDD][l * 4 + h];
    const bf16_t* Zb = (const bf16_t*)(P.ws + WS_Z);
    f32x4 yg[4][4];
#pragma unroll
    for (int strip = 0; strip < 4; ++strip) {
        const int i0 = 64 * half + 16 * strip, it = i0 >> 4;
        bf16x8 cmf[2];
#pragma unroll
        for (int ks = 0; ks < 2; ++ks) cmf[ks] = *(const bf16x8*)(XC + (size_t)(pr0 + i0 + fr) * 512 + 384 + 64 * g + 32 * ks + 8 * fq);
        f32x4 acc[4];
#pragma unroll
        for (int pt = 0; pt < 4; ++pt) { acc[pt] = (f32x4){0.f, 0.f, 0.f, 0.f};
#pragma unroll
            for (int ks = 0; ks < 2; ++ks) acc[pt] = MFMA16(cmf[ks], hpf[pt][ks], acc[pt]); }
        float csi[4];
#pragma unroll
        for (int e = 0; e < 4; ++e) { csi[e] = cs[(i0 + 4 * fq + e) * 4 + h]; const float ex = __expf(csi[e]);
#pragma unroll
            for (int pt = 0; pt < 4; ++pt) acc[pt][e] *= ex; }
        const int njt = (it | 1) + 1;
        for (int jt = 0; jt < njt; ++jt) {
            f32x4 sc = {0.f, 0.f, 0.f, 0.f};
#pragma unroll
            for (int ks = 0; ks < 2; ++ks) { const bf16x8 bmf = *(const bf16x8*)(XC + (size_t)(pr0 + 16 * jt + fr) * 512 + 256 + 64 * g + 32 * ks + 8 * fq); sc = MFMA16(cmf[ks], bmf, sc); }
            const int j = 16 * jt + fr; const float csj = cs[j * 4 + h], dj = dts[j * 4 + h];
#pragma unroll
            for (int e = 0; e < 4; ++e) { const int i = i0 + 4 * fq + e; const float v = (j <= i) ? sc[e] * __expf(csi[e] - csj) * dj : 0.f; scw[(4 * fq + e) * 136 + j] = (bf16_t)f2bf(v); }
        }
        LDS_WAIT(); asm volatile("" ::: "memory"); __syncthreads();
        for (int ks = 0; ks < (njt >> 1); ++ks) {
            const bf16x8 af = *(const LAS bf16x8*)(scw + fr * 136 + 32 * ks + 8 * fq);
#pragma unroll
            for (int pt = 0; pt < 4; ++pt) { const bf16x8 xf = *(const LAS bf16x8*)(xsT + (64 * h + 16 * pt + fr) * 136 + 32 * ks + 8 * fq); acc[pt] = MFMA16(af, xf, acc[pt]); }
        }
        float qs[4] = {0.f, 0.f, 0.f, 0.f};
#pragma unroll
        for (int pt = 0; pt < 4; ++pt)
#pragma unroll
            for (int e = 0; e < 4; ++e) {
                const int i = i0 + 4 * fq + e, p = 16 * pt + fr;
                const float xs = bf2f(xsT[(64 * h + p) * 136 + i]);
                const float z = bf2f(Zb[(size_t)(pr0 + i) * 256 + 64 * h + p]);
                const float v = (acc[pt][e] + Dh * xs) * siluf_(z);
                yg[strip][pt][e] = v; qs[e] += v * v;
            }
#pragma unroll
        for (int e = 0; e < 4; ++e) {
            float p = qs[e]; p += __shfl_xor(p, 1); p += __shfl_xor(p, 2); p += __shfl_xor(p, 4); p += __shfl_xor(p, 8);
            if (fr == 0) ssq4[(i0 + 4 * fq + e) * 4 + h] = p;
        }
        LDS_WAIT(); asm volatile("" ::: "memory"); __syncthreads();
    }
    __syncthreads();
    bf16_t* MIX = (bf16_t*)(P.ws + WS_MIX);
#pragma unroll
    for (int strip = 0; strip < 4; ++strip)
#pragma unroll
        for (int e = 0; e < 4; ++e) {
            const int i = 64 * half + 16 * strip + 4 * fq + e;
            const int r = pr_to_row(pr0 + i);
            const f32x4 t4 = *(const LAS f32x4*)(ssq4 + i * 4);
            const float rs = rsqrtf(((t4.x + t4.y) + (t4.z + t4.w)) * (1.0f / 256.0f) + EPS);
#pragma unroll
            for (int pt = 0; pt < 4; ++pt) {
                const int col = 64 * h + 16 * pt + fr;
                if (r >= 0) MIX[(size_t)r * DM + 768 + col] = (bf16_t)f2bf(yg[strip][pt][e] * rs * P.in[I_SSDG][l * 256 + col]);
            }
        }
    __syncthreads();
}

__device__ __forceinline__ void ssd_sample_unit(const Params& P, int l, int i, LAS unsigned char* lds) {
    const int tid = launder_tid(), lane = tid & 63, w = tid >> 6, pr = PR_SAMP + i;
    LAS float* xc = (LAS float*)lds;
    LAS float* ys = xc + 512;
    LAS float* red = ys + 256;
    {
        const int ch = tid;
        const float* cst = P.in[I_CONV] + ((size_t)l * 128 + i) * 3 * 512;
        const float s0 = cst[ch], s1 = cst[512 + ch], s2 = cst[1024 + ch];
        const float xn = bf2f(((const bf16_t*)(P.ws + WS_XBC))[(size_t)pr * 512 + ch]);
        const float v = P.in[I_CONVB][l * 512 + ch] + P.in[I_CONVW][(l * 4 + 0) * 512 + ch] * s0 + P.in[I_CONVW][(l * 4 + 1) * 512 + ch] * s1
                      + P.in[I_CONVW][(l * 4 + 2) * 512 + ch] * s2 + P.in[I_CONVW][(l * 4 + 3) * 512 + ch] * xn;
        xc[ch] = siluf_(v);
        float* oc = P.out + O_CONVS + ((size_t)l * 128 + i) * 3 * 512;
        oc[ch] = s1; oc[512 + ch] = s2;
    }
    LDS_WAIT(); __syncthreads();
    const float* DT = (const float*)(P.ws + WS_DT) + (size_t)pr * 4;
    const float* h0 = P.in[I_SSD] + ((size_t)l * 128 + i) * 16384; float* hout = P.out + O_SSDS + ((size_t)l * 128 + i) * 16384;
    for (int k = 0; k < 32; ++k) {
        const int rowi = w + 8 * k, h = rowi >> 6, p = rowi & 63, g = h >> 1;
        const float dt = softplusf_(DT[h] + P.in[I_DTB][l * 4 + h]);
        const float dA = __expf(-__expf(P.in[I_ALOG][l * 4 + h]) * dt);
        const float xs = xc[64 * h + p], bm = xc[256 + 64 * g + lane], cm = xc[384 + 64 * g + lane];
        const float hn = dA * h0[rowi * 64 + lane] + bm * dt * xs;
        hout[rowi * 64 + lane] = hn;
        const float y = wave_sum(cm * hn);
        if (lane == 0) ys[rowi] = y + P.in[I_SSDD][l * 4 + h] * xs;
    }
    LDS_WAIT(); __syncthreads();
    float v = 0.f;
    if (tid < 256) v = ys[tid] * siluf_(bf2f(((const bf16_t*)(P.ws + WS_Z))[(size_t)pr * 256 + tid]));
    const float qs = wave_sum(v * v);
    if (lane == 0) red[w] = qs;
    LDS_WAIT(); __syncthreads();
    const float tot = (red[0] + red[1]) + (red[2] + red[3]);
    const float rs = rsqrtf(tot * (1.0f / 256.0f) + EPS);
    if (tid < 256) ((bf16_t*)(P.ws + WS_MIX))[(size_t)(R_SAMP + i) * DM + 768 + tid] = (bf16_t)f2bf(v * rs * P.in[I_SSDG][l * 256 + tid]);
    __syncthreads();
}

__device__ __forceinline__ void final_phase(const Params& P) {
    const int lane = launder_tid() & 63, gw = launder_bid() * 8 + (launder_tid() >> 6), NGW = launder_gdim() * 8;
    const float* XF = (const float*)(P.ws + WS_XF); const float* ssq = (const float*)(P.ws + WS_SSQ); const float* g = P.in[I_LNF];
    for (int r = gw; r < R_VALID; r += NGW) {
        if (r >= R_META && r < R_SAMP) continue;
        float* o = r < R_META ? P.out + O_Y + (size_t)r * DM : P.out + O_YS + (size_t)(r - R_SAMP) * DM;
        const float rs = row_rs(ssq, r);
#pragma unroll
        for (int j = 0; j < 4; ++j) {
            const f32x4 v = *(const f32x4*)(XF + (size_t)r * DM + 256 * j + 4 * lane), gg = *(const f32x4*)(g + 256 * j + 4 * lane);
#ifdef DBG_OUTE5
            { const size_t fi = (size_t)r * DM + 256 * j + 4 * lane; const float* E5 = (const float*)(P.ws + DBG_OUTE5);
              f32x4 ev = {0.f, 0.f, 0.f, 0.f}; if (r < R_META && fi < (size_t)(DBG_OUTN)) ev = *(const f32x4*)(E5 + fi) * 3000.0f;
              *(f32x4*)(o + 256 * j + 4 * lane) = ev + 0.f * (v * rs * gg); }
#elif defined(DBG_OUTMIX)
            const u32x2 mw = *(const u32x2*)((const bf16_t*)(P.ws + WS_MIX) + (size_t)r * DM + 256 * j + 4 * lane);
            f32x4 mv = {bflo(mw.x), bfhi(mw.x), bflo(mw.y), bfhi(mw.y)};
            *(f32x4*)(o + 256 * j + 4 * lane) = mv + 0.f * (v * rs * gg);
#else
            *(f32x4*)(o + 256 * j + 4 * lane) = v * rs * gg;
#endif
        }
    }
}

constexpr int N_PHASES = 30;
#ifndef MK_ONE_LAUNCH
#define MK_ONE_LAUNCH 0
#endif
#ifndef PG_SP2
#define PG_SP2 true
#endif

__device__ __forceinline__ void run_phase(const Params& P, int ph, LAS unsigned char* lds) {
    unsigned char* ws = P.ws;
    if (ph == 0) { phase_prologue(P, lds); return; }
    if (ph == N_PHASES - 1) { final_phase(P); return; }
    const int l = (ph - 1) / 7, k = (ph - 1) % 7;
    const int G = launder_gdim(), bx = launder_bid();
    switch (k) {
    case 0: {
        pg8::Gemm g{(const bf16_t*)(ws + WS_XB), (const bf16_t*)(ws + WS_WIN) + (size_t)l * NIN * DM, MR, NIN, DM};
        pg8::StaticOrder S; S.init(MR, NIN, G, bx);
        EpiWin E{ws, P.out, l};
        pg8::gemm_phase<EpiWin, pg8::StaticOrder, true, PG_SP2>(lds, g, S, E);
        dt_rows(P, l);
        zero_pads(P, l);
    } break;
    case 1: {
        constexpr int NU = 130 + 260 + 130 + 128;
        for (int u = bx; u < NU; u += G) {
#ifdef DBG_RT
            if (u < 130) { if (!(P.dbg & 1)) continue; } else if (u >= 390 && u < 520) { if (P.dbg & 64) continue; } else if (u >= 520) { if (P.dbg & 128) continue; }
#endif
            if (u < 130) attn_prompt_unit(P, l, u / NCH, u % NCH, lds);
            else if (u < 390) { const int v = u - 130; s5_unit<false>(P, l, v / NCH5, v % NCH5, lds); }
            else if (u < 520) { const int v = u - 390; ssd_local_unit(P, l, v / NCH, v % NCH, lds); }
            else attn_sample_unit(P, l, u - 520, lds);
        }
    } break;
    case 2: carry_phase(P, l); break;
    case 3: {
        constexpr int NU = 260 + 130 + 128 + 128;
        for (int u = bx; u < NU; u += G) {
#ifdef DBG_RT
            if (u < 260) { if (!(P.dbg & 2)) continue; } else if (u < 390) { if (!(P.dbg & 4)) continue; }
#endif
            if (u < 260) s5_unit<true>(P, l, u / NCH5, u % NCH5, lds);
            else if (u < 390) { const int v = u - 260; ssd_out_unit(P, l, v / NCH, v % NCH, lds); }
            else if (u < 518) s5_sample_unit(P, l, u - 390, lds);
            else ssd_sample_unit(P, l, u - 518, lds);
        }
    } break;
    case 4: {
        pg8::Gemm g{(const bf16_t*)(ws + WS_MIX), (const bf16_t*)(ws + WS_WOUT) + (size_t)l * DM * DM, MR, DM, DM};
        pg8::StaticOrder S; S.init(MR, DM, G, bx);
        EpiRes E{ws, (LAS float*)(lds + LDS_RED)};
        pg8::gemm_phase<EpiRes, pg8::StaticOrder, true, PG_SP2>(lds, g, S, E);
    } break;
    case 5: {
        pg8::Gemm g{(const bf16_t*)(ws + WS_XB), (const bf16_t*)(ws + WS_WGU) + (size_t)l * NGU * DM, MR, NGU, DM};
        pg8::StaticOrder S; S.init(MR, NGU, G, bx);
        EpiGU E{ws};
        pg8::gemm_phase<EpiGU, pg8::StaticOrder, true, PG_SP2>(lds, g, S, E);
    } break;
    default: {
        pg8::Gemm g{(const bf16_t*)(ws + WS_H), (const bf16_t*)(ws + WS_WDN) + (size_t)l * DM * FFN, MR, DM, FFN};
        pg8::StaticOrder S; S.init(MR, DM, G, bx);
        EpiRes E{ws, (LAS float*)(lds + LDS_RED)};
        pg8::gemm_phase<EpiRes, pg8::StaticOrder, true, PG_SP2>(lds, g, S, E);
    } break;
    }
}

__global__ void __launch_bounds__(512, 2) fwd_kernel(Params P) {
    extern __shared__ __attribute__((aligned(16))) unsigned char lds_raw[];
    LAS unsigned char* lds = (LAS unsigned char*)lds_raw;
    cg::grid_group grid = cg::this_grid();
    for (int ph = P.ph_lo; ph < P.ph_hi; ++ph) {
        if (ph > P.ph_lo) {
            asm volatile("s_waitcnt vmcnt(0) lgkmcnt(0)" ::: "memory");
            __syncthreads();
            __threadfence();
            asm volatile("s_waitcnt vmcnt(0)" ::: "memory");
            grid.sync();
            __threadfence();
            asm volatile("s_waitcnt vmcnt(0)" ::: "memory");
            __syncthreads();
        }
        auto kp = __builtin_amdgcn_kernarg_segment_ptr();
        asm volatile("" : "+s"(kp));
        run_phase(*(const Params*)kp, ph, lds);
    }
}

extern "C" void kernel_launch(void* const* d_in, const int* in_sizes, int n_in, void* d_out, int out_size, void* d_ws, size_t ws_size, hipStream_t stream) {
    static int grid = 0;
    if (grid == 0) {
        if (n_in != 36 || (size_t)out_size != O_END || ws_size < WS_END) {
            fprintf(stderr, "kernel_launch: unexpected problem: n_in %d out %d ws %zu (need %zu)\n", n_in, out_size, ws_size, (size_t)WS_END); grid = -1; return;
        }
        int dev = 0, cus = 0, per_cu = 0;
        (void)hipGetDevice(&dev);
        (void)hipDeviceGetAttribute(&cus, hipDeviceAttributeMultiprocessorCount, dev);
        (void)hipFuncSetAttribute((const void*)fwd_kernel, hipFuncAttributeMaxDynamicSharedMemorySize, LDS_BYTES);
        (void)hipOccupancyMaxActiveBlocksPerMultiprocessor(&per_cu, (const void*)fwd_kernel, 512, LDS_BYTES);
        if (per_cu < 1) { fprintf(stderr, "kernel_launch: occupancy query says %d blocks per CU\n", per_cu); per_cu = 1; }
        (void)hipGetLastError();
        grid = cus;
    }
    if (grid < 0) return;
#ifdef DBG_POISON_LO
    (void)hipMemsetAsync((char*)d_ws + (size_t)(DBG_POISON_LO) * MiB, 0xAA, (size_t)(DBG_POISON_HI - DBG_POISON_LO) * MiB, stream);
#endif
    Params p{};
    for (int i = 0; i < 36; ++i) p.in[i] = (const float*)d_in[i];
    p.out = (float*)d_out; p.ws = (unsigned char*)d_ws;
#ifdef DBG_RT
    p.dbg = DBG_RT;
#endif
#if MK_ONE_LAUNCH
    p.ph_lo = 0; p.ph_hi = N_PHASES;
    void* args[] = {&p};
    hipError_t e = hipLaunchCooperativeKernel((const void*)fwd_kernel, dim3(grid), dim3(512), args, LDS_BYTES, stream);
    if (e != hipSuccess) fprintf(stderr, "cooperative launch failed: %s (grid %d)\n", hipGetErrorString(e), grid);
#ifdef DBG_TWICE
    e = hipLaunchCooperativeKernel((const void*)fwd_kernel, dim3(grid), dim3(512), args, LDS_BYTES, stream);
#endif
#else
    for (int ph = 0; ph < N_PHASES; ++ph) {
#ifdef DBG_PHASES
        if (!(ph == 0 || ph == N_PHASES - 1 || (ph < DBG_PHASES))) continue;
#endif
        p.ph_lo = ph; p.ph_hi = ph + 1;
        hipLaunchKernelGGL(fwd_kernel, dim3(grid), dim3(512), LDS_BYTES, stream, p);
    }
#endif
}
```

```cpp
#define MK_ONE_LAUNCH 1
#include <hip/hip_runtime.h>
#include <hip/hip_cooperative_groups.h>
#include <cstdio>
#include <cstdint>
namespace cg = cooperative_groups;

#define LAS __attribute__((address_space(3)))
typedef unsigned short bf16_t;
typedef short bf16x8 __attribute__((ext_vector_type(8)));
typedef short bf16x4 __attribute__((ext_vector_type(4)));
typedef float f32x4 __attribute__((ext_vector_type(4)));
typedef float f32x2 __attribute__((ext_vector_type(2)));
typedef float f32x16 __attribute__((ext_vector_type(16)));
typedef unsigned u32x4 __attribute__((ext_vector_type(4)));
typedef unsigned u32x2 __attribute__((ext_vector_type(2)));

constexpr int DM = 1024, NL = 4, SEQ = 8192, NMETA = 16, TT = SEQ + NMETA  , NB = 2, NS = 128;
constexpr int MR = 16640;
constexpr int R_META = 16384, R_SAMP = 16416, R_VALID = 16544;
constexpr int BPAD = 8320;
constexpr int PR = 2 * BPAD + NS;
constexpr int PR_SAMP = 2 * BPAD;
constexpr int NIN = 1792, NINSRC = 1796, FFN = 2816, NGU = 2 * FFN;
constexpr int NCH = 65;
constexpr int NCH5 = 130;
constexpr float EPS = 1e-6f;

constexpr size_t O_Y = 0, O_YS = 16777216, O_KP = 16908288, O_VP = 17039360, O_S5RP = 17170432, O_S5IP = 17178624, O_CONVP = 17186816,
                 O_SSDP = 17199104, O_KS = 17330176, O_VS = 25718784, O_S5RS = 34107392, O_S5IS = 34631680, O_CONVS = 35155968, O_SSDS = 35942400,
                 O_END = 44331008;

constexpr size_t MiB = 1u << 20;
constexpr size_t WS_CTL = 0;
constexpr size_t WS_WIN = 1 * MiB;
constexpr size_t WS_WOUT = 15 * MiB;
constexpr size_t WS_WGU = 23 * MiB;
constexpr size_t WS_WDN = 67 * MiB;
constexpr size_t WS_TAB = 89 * MiB;
constexpr size_t TAB_ROPEC = WS_TAB;
constexpr size_t TAB_ROPES = TAB_ROPEC + 8208 * 32 * 4;
constexpr size_t TAB_ABAR = TAB_ROPES + 8208 * 32 * 4;
constexpr size_t TAB_A64 = TAB_ABAR + 4 * 16 * 64 * 2 * 4;
constexpr size_t TAB_BBF = TAB_A64 + 4 * 16 * 64 * 2 * 4;
constexpr size_t TAB_BBP = TAB_BBF + 4 * 16 * 64 * 32 * 4;
constexpr size_t TAB_CC = TAB_BBP + 4 * 8 * 256 * 32 * 2;
constexpr size_t TAB_GLUT = TAB_CC + 4 * 16 * 16 * 128 * 2;
constexpr size_t TAB_WDT = TAB_GLUT + 4 * 256 * 256 * 2;
constexpr size_t TAB_END = TAB_WDT + 4 * 4 * 1024 * 4;
static_assert(TAB_END <= WS_TAB + 8 * MiB, "tables");
constexpr size_t WS_SSQ = 97 * MiB;
constexpr size_t WS_XF = 98 * MiB;
constexpr size_t WS_XB = 163 * MiB;
constexpr size_t WS_MIX = 196 * MiB;
constexpr size_t WS_R = 229 * MiB;
constexpr size_t WS_H = WS_R;
constexpr size_t WS_Q = WS_R;
constexpr size_t WS_K = WS_Q + (size_t)PR * 512 * 2;
constexpr size_t WS_VT = WS_K + (size_t)PR * 128 * 2;
constexpr size_t WS_U = WS_VT + (size_t)PR * 128 * 2;
constexpr size_t WS_Z = WS_U + (size_t)PR * 256 * 4;
constexpr size_t WS_XBC = WS_Z + (size_t)PR * 256 * 2;
constexpr size_t WS_XC = WS_XBC + (size_t)PR * 512 * 2;
constexpr size_t WS_DT = WS_XC + (size_t)PR * 512 * 2;
constexpr size_t WS_DTS = WS_DT + (size_t)PR * 4 * 4;
constexpr size_t WS_CS = WS_DTS + (size_t)PR * 4 * 4;
constexpr size_t WS_E5 = WS_CS + (size_t)PR * 4 * 4;
constexpr size_t WS_SLOC = WS_E5 + (size_t)2 * NCH5 * 16 * 64 * 2 * 4;
constexpr size_t WS_HP = WS_SLOC + (size_t)2 * NCH * 4 * 4096 * 4;
constexpr size_t WS_CD = WS_HP + (size_t)2 * NCH * 4 * 4096 * 4;
constexpr size_t WS_H05 = WS_CD + 4096;
constexpr size_t WS_MIXEND = WS_H05 + (size_t)2 * NCH5 * 16 * 64 * 2 * 4;
constexpr size_t WS_HEND = WS_R + (size_t)MR * FFN * 2;
constexpr size_t WS_END = WS_MIXEND > WS_HEND ? WS_MIXEND : WS_HEND;

__device__ __forceinline__ unsigned f2bf(float f) { unsigned u = __builtin_bit_cast(unsigned, f); return (u + 0x7fffu + ((u >> 16) & 1u)) >> 16; }
__device__ __forceinline__ unsigned pk2(float lo, float hi) { return f2bf(lo) | (f2bf(hi) << 16); }
__device__ __forceinline__ float bf2f(unsigned short b) { return __builtin_bit_cast(float, (unsigned)b << 16); }
__device__ __forceinline__ float bflo(unsigned w) { return __builtin_bit_cast(float, w << 16); }
__device__ __forceinline__ float bfhi(unsigned w) { return __builtin_bit_cast(float, w & 0xffff0000u); }
__device__ __forceinline__ float wave_sum(float v) {
#pragma unroll
    for (int o = 1; o < 64; o <<= 1) v += __shfl_xor(v, o);
    return v;
}
__device__ __forceinline__ float wave_max(float v) {
#pragma unroll
    for (int o = 1; o < 64; o <<= 1) v = fmaxf(v, __shfl_xor(v, o));
    return v;
}
__device__ __forceinline__ float sigmoidf_(float x) { return 1.0f / (1.0f + __expf(-x)); }
__device__ __forceinline__ float siluf_(float x) { return x / (1.0f + __expf(-x)); }
__device__ __forceinline__ float softplusf_(float x) { return fmaxf(x, 0.f) + __logf(1.0f + __expf(-fabsf(x))); }
__device__ __forceinline__ float gelu_tanh(float x) {
    const float u = 0.7978845608028654f * (x + 0.044715f * x * x * x);
    const float e = __expf(2.0f * u);
    const float t = 1.0f - 2.0f / (e + 1.0f);
    return 0.5f * x * (1.0f + t);
}
__device__ __forceinline__ void sincos_red(double ang, float& s, float& c) {
    const double k = __builtin_rint(ang * 0.15915494309189535);
    const double r = __builtin_fma(-k, 6.283185307179586, ang) - k * 2.4492935982947064e-16;
    const float rf = (float)r;
    s = sinf(rf); c = cosf(rf);
}
__device__ __forceinline__ int row_to_pr(int r, int& pos) {
    if (r < R_META) { const int b = r >> 13, s = r & 8191; pos = s + 16; return b * BPAD + 128 + s; }
    if (r < R_SAMP) { const int b = (r - R_META) >> 4, t = (r - R_META) & 15; pos = t; return b * BPAD + 112 + t; }
    if (r < R_VALID) { pos = SEQ; return PR_SAMP + (r - R_SAMP); }
    pos = 0; return -1;
}
__device__ __forceinline__ int pr_to_row(int pr) {
    const int b = pr >= BPAD ? 1 : 0, lq = pr - b * BPAD, t = lq - 112;
    if (t < 0) return -1;
    return t < 16 ? R_META + b * 16 + t : b * SEQ + (t - 16);
}
__device__ __forceinline__ bf16x8 ld_bf16x8_f32(const float* p) {
    const f32x4 a = *(const f32x4*)p, b = *(const f32x4*)(p + 4);
    u32x4 w; w.x = pk2(a.x, a.y); w.y = pk2(a.z, a.w); w.z = pk2(b.x, b.y); w.w = pk2(b.z, b.w);
    return __builtin_bit_cast(bf16x8, w);
}
__device__ __forceinline__ int launder_tid() { int t = threadIdx.x; asm volatile("" : "+v"(t)); return t; }
__device__ __forceinline__ size_t ws_u_off(int l) {
#ifdef DBG_USPLIT
    return l == 0 ? WS_U : WS_WGU + 24 * MiB;
#else
    return WS_U;
#endif
}
__device__ __forceinline__ size_t ws_e5_off(int l) {
#ifdef DBG_E5SPLIT
    return l == 0 ? WS_E5 : WS_WGU + 24 * MiB;
#else
    return WS_E5;
#endif
}
__device__ __forceinline__ int launder_bid() { int t = blockIdx.x; asm volatile("" : "+s"(t)); return t; }
__device__ __forceinline__ int launder_gdim() { int t = gridDim.x; asm volatile("" : "+s"(t)); return t; }
#define MFMA16(a, b, c) __builtin_amdgcn_mfma_f32_16x16x32_bf16((a), (b), (c), 0, 0, 0)
#define MFMA32(a, b, c) __builtin_amdgcn_mfma_f32_32x32x16_bf16((a), (b), (c), 0, 0, 0)
#ifdef DBG_NOSETTLE
#define MFMA_SETTLE(x) do {} while (0)
#else
#define MFMA_SETTLE(x) asm volatile("s_nop 15\n\ts_nop 15" : "+v"(x))
#endif
#define LDS_WAIT() asm volatile("s_waitcnt lgkmcnt(0)" ::: "memory")

namespace pg8 {
#define PG8_LAS __attribute__((address_space(3)))
typedef unsigned short bf16_t;
typedef short bf16x8 __attribute__((ext_vector_type(8)));
typedef float f32x4 __attribute__((ext_vector_type(4)));
typedef unsigned u32x4 __attribute__((ext_vector_type(4)));
constexpr int BM = 256, BK = 64, HALF = 128, HTB = HALF * BK * 2  , STAGE_BYTES = 8 * HTB, NXCD = 8, WGM = 8;

__host__ __device__ __forceinline__ int lds_byte(int r, int c) { const int st = (r >> 4) * 2 + (c >> 5), rr = r & 15, cc = c & 31, ob = rr * 64 + cc * 2; return st * 1024 + (ob ^ (((ob >> 9) & 1) << 5)); }
__host__ __device__ __forceinline__ void stage_rc(int b, int& R, int& C) { const int st = b / 1024, sb = b % 1024, swz = sb ^ (((sb >> 9) & 1) << 5); R = (st >> 1) * 16 + swz / 64; C = (st & 1) * 32 + (swz % 64) / 2; }
__host__ __device__ __forceinline__ int perm32(int rho) { const int n = rho >> 4, i = rho & 15; return 8 * (i >> 2) + 4 * n + (i & 3); }

struct Unit { int pm, pn; };
struct Gemm { const bf16_t* A; const bf16_t* Bt; int M, N, K; };

struct StaticOrder {
    int nM, nN, nwg, G, c;
    __host__ __device__ void init(int M, int N, int G_, int c_) { nM = M / BM; nN = N / BM; nwg = nM * nN; G = G_; c = c_; }
    __host__ __device__ bool next(int i, Unit& u) const {
        const long L = (long)i * G + c; if (L >= nwg) return false;
        int wgid = (int)L; { const int q = nwg / NXCD, r = nwg % NXCD, xcd = wgid % NXCD, off = wgid / NXCD; wgid = (xcd < r ? xcd * (q + 1) : r * (q + 1) + (xcd - r) * q) + off; }
        const int nig = WGM * nN, gid = wgid / nig, fm = gid * WGM, gsz = (nM - fm) < WGM ? (nM - fm) : WGM;
        u.pm = fm + ((wgid % nig) % gsz); u.pn = (wgid % nig) / gsz; return true;
    }
    __device__ __forceinline__ void a_ready(const Unit&) const {}
    __device__ __forceinline__ void done(const Unit&) const {}
};

__device__ __forceinline__ unsigned cvt_pk_bf16(float lo, float hi) { unsigned r; asm volatile("v_cvt_pk_bf16_f32 %0, %1, %2" : "=v"(r) : "v"(lo), "v"(hi)); return r; }
template <class Epi, class Sched, bool ALIGN_EPI = false, bool SP2 = false>
__device__ __forceinline__ void gemm_phase(PG8_LAS unsigned char* lds, const Gemm g, const Sched& S, const Epi& E) {
    const int tid = launder_tid(), wid = __builtin_amdgcn_readfirstlane(tid >> 6), lane = tid & 63, wr = wid >> 2, wc = wid & 3, fr = lane & 15, fq = lane >> 4;
    const int K = g.K, nt = K / BK;
    unsigned voffA[2], voffB[2];
#pragma unroll
    for (int i = 0; i < 2; ++i) { int R, C; stage_rc(tid * 16 + i * 8192, R, C); const int Rb = Epi::PERM ? ((R & ~31) + perm32(R & 31)) : R;
        voffA[i] = (unsigned)(R * K + C) * 2u; voffB[i] = (unsigned)(Rb * K + C) * 2u; }
    const size_t kstep = (size_t)(BK * 2);
    const size_t hstep = (size_t)HALF * K * 2;
    const size_t tstep = 2 * hstep;
    const unsigned ldsw = (unsigned)wid * 1024u;
    const int aoff = lds_byte(wr * 64 + fr, fq * 8), boff = lds_byte(wc * 32 + fr, fq * 8);
#define PG8_SA(b, h) (((b) * 2 + (h)) * HTB)
#define PG8_SB(b, h) ((4 + (b) * 2 + (h)) * HTB)
#define PG8_STAGE(bufoff, gbase, voff) do { _Pragma("unroll") for (int _i = 0; _i < 2; ++_i) \
        __builtin_amdgcn_global_load_lds((const unsigned*)((const char*)(gbase) + (voff)[_i]), (PG8_LAS unsigned*)(lds + (bufoff) + ldsw + _i * 8192), 16, 0, 0); } while (0)
#define PG8_LDA(dst, b, h) do { _Pragma("unroll") for (int m = 0; m < 4; ++m) _Pragma("unroll") for (int k = 0; k < 2; ++k) dst[m][k] = *(const PG8_LAS bf16x8*)(lds + PG8_SA(b, h) + aoff + m * 2048 + k * 1024); } while (0)
#define PG8_LDB(dst, b, h) do { _Pragma("unroll") for (int n = 0; n < 2; ++n) _Pragma("unroll") for (int k = 0; k < 2; ++k) dst[n][k] = *(const PG8_LAS bf16x8*)(lds + PG8_SB(b, h) + boff + n * 2048 + k * 1024); } while (0)
#define PG8_MMA(ai, bj, At, Bt) do { __builtin_amdgcn_s_setprio(1); _Pragma("unroll") for (int m = 0; m < 4; ++m) _Pragma("unroll") for (int n = 0; n < 2; ++n) _Pragma("unroll") for (int k = 0; k < 2; ++k) \
        acc[ai][bj][m][n] = __builtin_amdgcn_mfma_f32_16x16x32_bf16(Bt[n][k], At[m][k], acc[ai][bj][m][n], 0, 0, 0); __builtin_amdgcn_s_setprio(0); } while (0)
#define PG8_WAIT_V(n) asm volatile("s_waitcnt vmcnt(" #n ")" ::: "memory")
#define PG8_WAIT_L(n) asm volatile("s_waitcnt lgkmcnt(" #n ")" ::: "memory")
#define PG8_BAR __builtin_amdgcn_s_barrier()
#define PG8_SCHED __builtin_amdgcn_sched_barrier(0)
    Unit cur, nxt; int ui = 0;
    if (!S.next(0, cur)) return;
    f32x4 acc[2][2][4][2];
#pragma unroll
    for (int a = 0; a < 2; ++a)
#pragma unroll
        for (int b = 0; b < 2; ++b)
#pragma unroll
            for (int m = 0; m < 4; ++m)
#pragma unroll
                for (int n = 0; n < 2; ++n) acc[a][b][m][n] = (f32x4){0.f, 0.f, 0.f, 0.f};
    bf16x8 At[4][2], B0[2][2], B1[2][2];
    const char* cA = (const char*)g.A + (size_t)cur.pm * tstep; const char* cB = (const char*)g.Bt + (size_t)cur.pn * tstep;
    S.a_ready(cur);
    if constexpr (SP2) {
        PG8_STAGE(PG8_SB(0, 0), cB, voffB); PG8_STAGE(PG8_SB(0, 1), cB + hstep, voffB); PG8_STAGE(PG8_SA(0, 0), cA, voffA); PG8_STAGE(PG8_SA(0, 1), cA + hstep, voffA);
        if (wr == 1) PG8_BAR;
        PG8_WAIT_V(2); PG8_BAR;
        PG8_STAGE(PG8_SB(1, 0), cB + kstep, voffB); PG8_STAGE(PG8_SA(1, 0), cA + kstep, voffA); PG8_STAGE(PG8_SB(1, 1), cB + hstep + kstep, voffB);
        PG8_WAIT_V(6); PG8_BAR;
    } else {
        PG8_STAGE(PG8_SB(0, 0), cB, voffB); PG8_STAGE(PG8_SA(0, 0), cA, voffA); PG8_STAGE(PG8_SB(0, 1), cB + hstep, voffB); PG8_STAGE(PG8_SA(0, 1), cA + hstep, voffA);
        if (wr == 1) PG8_BAR;
        PG8_WAIT_V(4); PG8_BAR;
        PG8_STAGE(PG8_SB(1, 0), cB + kstep, voffB); PG8_STAGE(PG8_SA(1, 0), cA + kstep, voffA); PG8_STAGE(PG8_SB(1, 1), cB + hstep + kstep, voffB);
        PG8_WAIT_V(6); PG8_BAR;
    }
    for (;;) {
        const bool has_next = S.next(ui + 1, nxt);
        const char* nA = has_next ? (const char*)g.A + (size_t)nxt.pm * tstep : cA; const char* nB = has_next ? (const char*)g.Bt + (size_t)nxt.pn * tstep : cB;
        for (int t = 0; t < nt; t += 2) {
            const bool last = (t == nt - 2);
            const char* a1 = cA + (size_t)(t + 1) * kstep;
            const char* a2 = last ? nA : cA + (size_t)(t + 2) * kstep; const char* b2 = last ? nB : cB + (size_t)(t + 2) * kstep;
            const char* a3 = a2 + kstep; const char* b3 = b2 + kstep;
            if (last && has_next) S.a_ready(nxt);
            if constexpr (SP2) {
            PG8_LDB(B0, 0, 0); PG8_LDB(B1, 0, 1); PG8_SCHED; PG8_LDA(At, 0, 0); PG8_STAGE(PG8_SA(1, 1), a1 + hstep, voffA);
            PG8_WAIT_V(8); PG8_WAIT_L(0); PG8_BAR; PG8_MMA(0, 0, At, B0); PG8_MMA(0, 1, At, B1); PG8_BAR; PG8_SCHED;
            PG8_LDA(At, 0, 1); PG8_STAGE(PG8_SB(0, 0), b2, voffB); PG8_STAGE(PG8_SB(0, 1), b2 + hstep, voffB); PG8_STAGE(PG8_SA(0, 0), a2, voffA);
            PG8_WAIT_V(8); PG8_WAIT_L(0); PG8_BAR; PG8_MMA(1, 0, At, B0); PG8_MMA(1, 1, At, B1); PG8_BAR; PG8_SCHED;
            PG8_LDB(B0, 1, 0); PG8_LDB(B1, 1, 1); PG8_SCHED; PG8_LDA(At, 1, 0); PG8_STAGE(PG8_SA(0, 1), a2 + hstep, voffA);
            PG8_WAIT_V(8); PG8_WAIT_L(0); PG8_BAR; PG8_MMA(0, 0, At, B0); PG8_MMA(0, 1, At, B1); PG8_BAR; PG8_SCHED;
            PG8_LDA(At, 1, 1); PG8_STAGE(PG8_SB(1, 0), b3, voffB); PG8_STAGE(PG8_SB(1, 1), b3 + hstep, voffB); PG8_STAGE(PG8_SA(1, 0), a3, voffA);
            PG8_WAIT_V(8); PG8_WAIT_L(0); PG8_BAR; PG8_MMA(1, 0, At, B0); PG8_MMA(1, 1, At, B1); PG8_BAR; PG8_SCHED;
            } else {
            PG8_LDB(B0, 0, 0); PG8_SCHED; PG8_LDA(At, 0, 0); PG8_STAGE(PG8_SA(1, 1), a1 + hstep, voffA);
            PG8_WAIT_L(8); PG8_BAR; PG8_WAIT_L(0); PG8_MMA(0, 0, At, B0); PG8_BAR; PG8_SCHED;
            PG8_LDB(B1, 0, 1); PG8_STAGE(PG8_SB(0, 0), b2, voffB);
            PG8_BAR; PG8_WAIT_L(0); PG8_MMA(0, 1, At, B1); PG8_BAR;
            PG8_LDA(At, 0, 1); PG8_STAGE(PG8_SA(0, 0), a2, voffA);
            PG8_BAR; PG8_WAIT_L(0); PG8_MMA(1, 0, At, B0); PG8_BAR; PG8_SCHED;
            PG8_STAGE(PG8_SB(0, 1), b2 + hstep, voffB);
            PG8_WAIT_V(6); PG8_BAR; PG8_MMA(1, 1, At, B1); PG8_BAR;
            PG8_LDB(B0, 1, 0); PG8_SCHED; PG8_LDA(At, 1, 0); PG8_STAGE(PG8_SA(0, 1), a2 + hstep, voffA);
            PG8_WAIT_L(8); PG8_BAR; PG8_WAIT_L(0); PG8_MMA(0, 0, At, B0); PG8_BAR; PG8_SCHED;
            PG8_LDB(B1, 1, 1); PG8_STAGE(PG8_SB(1, 0), b3, voffB);
            PG8_BAR; PG8_WAIT_L(0); PG8_MMA(0, 1, At, B1); PG8_BAR;
            PG8_LDA(At, 1, 1); PG8_STAGE(PG8_SA(1, 0), a3, voffA);
            PG8_BAR; PG8_WAIT_L(0); PG8_MMA(1, 0, At, B0); PG8_BAR; PG8_SCHED;
            PG8_STAGE(PG8_SB(1, 1), b3 + hstep, voffB);
            PG8_WAIT_V(6); PG8_BAR; PG8_MMA(1, 1, At, B1); PG8_BAR;
            }
        }
        if constexpr (ALIGN_EPI) { if (wr == 0) PG8_BAR; }
        if constexpr (!Epi::AFTER_DRAIN) { E(acc, cur, wr, wc, fr, fq); S.done(cur); }
        if (!has_next) break;
#pragma unroll
        for (int a = 0; a < 2; ++a)
#pragma unroll
            for (int b = 0; b < 2; ++b)
#pragma unroll
                for (int m = 0; m < 4; ++m)
#pragma unroll
                    for (int n = 0; n < 2; ++n) acc[a][b][m][n] = (f32x4){0.f, 0.f, 0.f, 0.f};
        cur = nxt; cA = nA; cB = nB; ++ui;
        if constexpr (ALIGN_EPI) { if (wr == 1) PG8_BAR; }
    }
    PG8_WAIT_V(0);
    if constexpr (!ALIGN_EPI) { if (wr == 0) PG8_BAR; }
    PG8_BAR;
    if constexpr (Epi::AFTER_DRAIN) { E.fused(acc, cur, wr, wc, fr, fq, lds, wid, lane); S.done(cur); }
#undef PG8_SA
#undef PG8_SB
#undef PG8_STAGE
#undef PG8_LDA
#undef PG8_LDB
#undef PG8_MMA
#undef PG8_WAIT_V
#undef PG8_WAIT_L
#undef PG8_BAR
#undef PG8_SCHED
}
}

struct Params {
    const float* in[36];
    float* out;
    unsigned char* ws;
    int ph_lo, ph_hi;
    int dbg, pad0;
};
enum { I_XP = 0, I_XS, I_CK, I_CV, I_S5R, I_S5I, I_CONV, I_SSD, I_META, I_LN1, I_WIN, I_SINK, I_ATTG, I_ARE, I_AIM, I_LOGDT, I_BRE, I_BIM, I_CRE, I_CIM,
       I_S5D, I_GLUW, I_GLUB, I_S5G, I_CONVW, I_CONVB, I_DTB, I_ALOG, I_SSDD, I_SSDG, I_WOUT, I_LN2, I_WG, I_WU, I_WD, I_LNF };

constexpr int LDS_BYTES = 147456;
constexpr int LDS_RED = 131072;

__device__ __forceinline__ float row_rs(const float* ssq, int r) {
    const float s = (ssq[r] + ssq[MR + r]) + (ssq[2 * MR + r] + ssq[3 * MR + r]);
    return rsqrtf(s * (1.0f / DM) + EPS);
}

struct EpiWin {
    static constexpr bool PERM = false, AFTER_DRAIN = false;
    unsigned char* wsb; float* outb; int layer;
    __device__ __forceinline__ void operator()(const f32x4 (&acc)[2][2][4][2], const pg8::Unit& u, int wr, int wc, int fr, int fq) const {
        asm volatile("" : "+v"(fr), "+v"(fq));
        unsigned char* ws = wsb; float* out = outb; asm volatile("" : "+s"(ws), "+s"(out));
        const float* ssq = (const float*)(ws + WS_SSQ); bf16_t* Q = (bf16_t*)(ws + WS_Q); bf16_t* Kb = (bf16_t*)(ws + WS_K); bf16_t* Vt = (bf16_t*)(ws + WS_VT);
        bf16_t* Zb = (bf16_t*)(ws + WS_Z); bf16_t* XBCb = (bf16_t*)(ws + WS_XBC); float* U = (float*)(ws + ws_u_off(layer));
        const float* ropec = (const float*)(ws + TAB_ROPEC); const float* ropes = (const float*)(ws + TAB_ROPES);
        const int pn = u.pn;
#pragma unroll
        for (int ai = 0; ai < 2; ++ai)
#pragma unroll
            for (int m = 0; m < 4; ++m) {
                const int r = u.pm * 256 + ai * 128 + wr * 64 + m * 16 + fr;
                int pos; const int pr = row_to_pr(r, pos);
                if (pr < 0) continue;
                const float rs = row_rs(ssq, r);
                if (pn <= 2) {
                    const int d1 = 16 * (wc & 1) + 4 * fq;
                    const f32x4 c4 = *(const f32x4*)(ropec + (size_t)pos * 32 + d1), s4 = *(const f32x4*)(ropes + (size_t)pos * 32 + d1);
                    const int nb = pn < 2 ? 2 : 1;
#pragma unroll
                    for (int bj = 0; bj < 2; ++bj) {
                        if (bj >= nb) break;
                        const f32x4 x1 = acc[ai][bj][m][0] * rs, x2 = acc[ai][bj][m][1] * rs;
                        const f32x4 o1 = x1 * c4 - x2 * s4, o2 = x2 * c4 + x1 * s4;
                        u32x2 w1, w2; w1.x = pk2(o1.x, o1.y); w1.y = pk2(o1.z, o1.w); w2.x = pk2(o2.x, o2.y); w2.y = pk2(o2.z, o2.w);
                        if (pn < 2) {
                            const int head = 4 * pn + 2 * bj + (wc >> 1);
                            bf16_t* qp = Q + (size_t)pr * 512 + head * 64 + d1;
                            *(u32x2*)qp = w1; *(u32x2*)(qp + 32) = w2;
                        } else {
                            const int kvh = wc >> 1;
                            bf16_t* kp = Kb + (size_t)pr * 128 + kvh * 64 + d1;
                            *(u32x2*)kp = w1; *(u32x2*)(kp + 32) = w2;
                            if (r < R_META && pos >= TT - 128) {
                                float* o = out + O_KP + ((size_t)(layer * 2 + (r >> 13)) * 128 + (pos - (TT - 128))) * 128 + kvh * 64 + d1;
                                *(f32x4*)o = o1; *(f32x4*)(o + 32) = o2;
                            }
                            if (r >= R_SAMP) {
                                float* o = out + O_KS + (((size_t)layer * 128 + (r - R_SAMP)) * 128 + 127) * 128 + kvh * 64 + d1;
                                *(f32x4*)o = o1; *(f32x4*)(o + 32) = o2;
                            }
                        }
                    }
                    if (pn == 2) {
#pragma unroll
                        for (int n = 0; n < 2; ++n) {
                            const int c = 32 * wc + 16 * n + 4 * fq;
                            const f32x4 v = acc[ai][1][m][n] * rs;
                            bf16_t* vp = Vt + (size_t)c * PR + pr;
                            vp[0] = (bf16_t)f2bf(v.x); vp[PR] = (bf16_t)f2bf(v.y); vp[2 * (size_t)PR] = (bf16_t)f2bf(v.z); vp[3 * (size_t)PR] = (bf16_t)f2bf(v.w);
                            if (r < R_META && pos >= TT - 128)
                                *(f32x4*)(out + O_VP + ((size_t)(layer * 2 + (r >> 13)) * 128 + (pos - (TT - 128))) * 128 + c) = v;
                            if (r >= R_SAMP)
                                *(f32x4*)(out + O_VS + (((size_t)layer * 128 + (r - R_SAMP)) * 128 + 127) * 128 + c) = v;
                        }
                    }
                } else {
#pragma unroll
                    for (int bj = 0; bj < 2; ++bj)
#pragma unroll
                        for (int n = 0; n < 2; ++n) {
                            const int c = 128 * bj + 32 * wc + 16 * n + 4 * fq;
                            const f32x4 v = acc[ai][bj][m][n] * rs;
                            if (pn == 3) { *(f32x4*)(U + (size_t)pr * 256 + c) = v; }
                            else {
                                u32x2 w; w.x = pk2(v.x, v.y); w.y = pk2(v.z, v.w);
                                if (pn == 4) { *(u32x2*)(Zb + (size_t)pr * 256 + c) = w; }
                                else {
                                    const int cc = (pn - 5) * 256 + c;
                                    *(u32x2*)(XBCb + (size_t)pr * 512 + cc) = w;
                                    if (r < R_META && pos >= TT - 3)
                                        *(f32x4*)(out + O_CONVP + ((size_t)(layer * 2 + (r >> 13)) * 3 + (pos - (TT - 3))) * 512 + cc) = v;
                                    if (r >= R_SAMP)
                                        *(f32x4*)(out + O_CONVS + (((size_t)layer * 128 + (r - R_SAMP)) * 3 + 2) * 512 + cc) = v;
                                }
                            }
                        }
                }
            }
    }
};

struct EpiRes {
    static constexpr bool PERM = false, AFTER_DRAIN = false;
    unsigned char* wsb; LAS float* red;
    __device__ __forceinline__ void operator()(const f32x4 (&acc)[2][2][4][2], const pg8::Unit& u, int wr, int wc, int fr, int fq) const {
        asm volatile("" : "+v"(fr), "+v"(fq));
        unsigned char* ws = wsb; asm volatile("" : "+s"(ws));
        float* XF = (float*)(ws + WS_XF); bf16_t* XB = (bf16_t*)(ws + WS_XB); float* ssq = (float*)(ws + WS_SSQ);
        const int col0 = u.pn * 256 + wc * 32 + 4 * fq;
#pragma unroll
        for (int ai = 0; ai < 2; ++ai)
#pragma unroll
            for (int m = 0; m < 4; ++m) {
                const int rl = ai * 128 + wr * 64 + m * 16 + fr;
                const size_t off = (size_t)(u.pm * 256 + rl) * DM + col0;
                float q = 0.f;
#pragma unroll
                for (int bj = 0; bj < 2; ++bj)
#pragma unroll
                    for (int n = 0; n < 2; ++n) {
                        float* xp = XF + off + bj * 128 + n * 16;
                        f32x4 x = *(const f32x4*)xp; x = x + acc[ai][bj][m][n];
                        *(f32x4*)xp = x;
                        q += (x.x * x.x + x.y * x.y) + (x.z * x.z + x.w * x.w);
                        u32x2 w; w.x = pk2(x.x, x.y); w.y = pk2(x.z, x.w);
                        *(u32x2*)(XB + off + bj * 128 + n * 16) = w;
                    }
                q += __shfl_xor(q, 16); q += __shfl_xor(q, 32);
                if (fq == 0) red[rl * 4 + wc] = q;
            }
        LDS_WAIT(); __builtin_amdgcn_s_barrier(); asm volatile("" ::: "memory");
        const int t = launder_tid();
        if (t < 256) { const f32x4 v = *(const LAS f32x4*)(red + t * 4); ssq[(size_t)u.pn * MR + u.pm * 256 + t] = (v.x + v.y) + (v.z + v.w); }
        LDS_WAIT(); __builtin_amdgcn_s_barrier(); asm volatile("" ::: "memory");
    }
};

struct EpiGU {
    static constexpr bool PERM = false, AFTER_DRAIN = false;
    unsigned char* wsb;
    __device__ __forceinline__ void operator()(const f32x4 (&acc)[2][2][4][2], const pg8::Unit& u, int wr, int wc, int fr, int fq) const {
        asm volatile("" : "+v"(fr), "+v"(fq));
        unsigned char* ws = wsb; asm volatile("" : "+s"(ws));
        const float* ssq = (const float*)(ws + WS_SSQ); bf16_t* H = (bf16_t*)(ws + WS_H);
        const int hcol = u.pn * 128 + wc * 32 + 8 * fq;
#pragma unroll
        for (int ai = 0; ai < 2; ++ai)
#pragma unroll
            for (int m = 0; m < 4; ++m) {
                const int r = u.pm * 256 + ai * 128 + wr * 64 + m * 16 + fr;
                const float rs = row_rs(ssq, r);
                float hv[8];
#pragma unroll
                for (int n = 0; n < 2; ++n) {
                    const f32x4 g = acc[ai][0][m][n] * rs, up = acc[ai][1][m][n] * rs;
#pragma unroll
                    for (int e = 0; e < 4; ++e) hv[4 * n + e] = siluf_(g[e]) * up[e];
#ifdef DBG_HFILL
#pragma unroll
                    for (int e = 0; e < 4; ++e) hv[4 * n + e] = 0.01f * (float)((r + hcol + 4 * n + e) & 15);
#endif
                }
                u32x4 w; w.x = pk2(hv[0], hv[1]); w.y = pk2(hv[2], hv[3]); w.z = pk2(hv[4], hv[5]); w.w = pk2(hv[6], hv[7]);
                *(u32x4*)(H + (size_t)r * FFN + hcol) = w;
            }
    }
};

__device__ const double ROPE_INV[32] = {1.0, 0.7498942093324559, 0.5623413251903491, 0.4216965034285822, 0.31622776601683794, 0.23713737056616552, 0.1778279410038923,
    0.1333521432163324, 0.1, 0.07498942093324558, 0.05623413251903491, 0.042169650342858224, 0.03162277660168379, 0.023713737056616554, 0.01778279410038923,
    0.01333521432163324, 0.01, 0.007498942093324558, 0.005623413251903491, 0.004216965034285823, 0.0031622776601683794, 0.0023713737056616554, 0.0017782794100389228,
    0.001333521432163324, 0.001, 0.0007498942093324559, 0.0005623413251903491, 0.00042169650342858224, 0.00031622776601683794, 0.00023713737056616554,
    0.00017782794100389227, 0.0001333521432163324};

__device__ __forceinline__ int win_src(int j) {
    const int pn = j >> 8, rho = j & 255;
    if (pn < 2 || (pn == 2 && rho < 128)) {
        const int bj = rho >> 7, wc = (rho >> 5) & 3, n = (rho >> 4) & 1, fq = (rho >> 2) & 3, e = rho & 3;
        const int d = 16 * (wc & 1) + 4 * fq + e + 32 * n;
        if (pn < 2) return 64 * (4 * pn + 2 * bj + (wc >> 1)) + d;
        return 512 + 64 * (wc >> 1) + d;
    }
    if (pn == 2) return 640 + (rho - 128);
    if (pn == 3) return 768 + rho;
    if (pn == 4) return 1024 + rho;
    return 1280 + 256 * (pn - 5) + rho;
}
__device__ __forceinline__ int gu_hidden(int j) {
    const int pn = j >> 8, q = j & 127, wc = q >> 5, n = (q >> 4) & 1, fq = (q >> 2) & 3, e = q & 3;
    return 128 * pn + 32 * wc + 8 * fq + 4 * n + e;
}
template <int MODE>
__device__ __forceinline__ void cvt_load(const float* W, const float* W2, int Nsrc, const float* gain, LAS float* scr, int item, int njb, int lane) {
    const int kb = item / njb, jb = item % njb, k0 = 64 * kb, j0 = 32 * jb;
    const int jj = j0 + (lane & 31);
    int src; const float* Wp = W;
    if (MODE == 0) src = win_src(jj);
    else if (MODE == 1) src = jj;
    else { src = gu_hidden(jj); if ((jj >> 7) & 1) Wp = W2; }
#pragma unroll 8
    for (int i = 0; i < 32; ++i) {
        const int kk = 2 * i + (lane >> 5);
        float v = Wp[(size_t)(k0 + kk) * Nsrc + src];
        if (gain) v *= gain[k0 + kk];
        scr[kk * 33 + (lane & 31)] = v;
    }
}
__device__ __forceinline__ void cvt_store(int K, bf16_t* WT, const LAS float* scr, int item, int njb, int lane) {
    const int kb = item / njb, jb = item % njb, k0 = 64 * kb, j0 = 32 * jb;
    const int c = lane & 7;
#pragma unroll
    for (int q = 0; q < 4; ++q) {
        const int n = (lane >> 3) + 8 * q; const LAS float* s = scr + (8 * c) * 33 + n;
        u32x4 o; o.x = pk2(s[0 * 33], s[1 * 33]); o.y = pk2(s[2 * 33], s[3 * 33]); o.z = pk2(s[4 * 33], s[5 * 33]); o.w = pk2(s[6 * 33], s[7 * 33]);
        *(u32x4*)(WT + (size_t)(j0 + n) * K + k0 + 8 * c) = o;
    }
}

__device__ __forceinline__ void phase_prologue(const Params& P, LAS unsigned char* lds) {
    const int tid = launder_tid(), lane = tid & 63, wave = tid >> 6;
    const int gw = launder_bid() * 8 + wave, NGW = launder_gdim() * 8;
    const int gt = launder_bid() * 512 + tid, NGT = launder_gdim() * 512;
    unsigned char* ws = P.ws;
    LAS float* scr = (LAS float*)(lds + wave * 8448);
    constexpr int I_IN = 16 * 56, I_OUT = 16 * 32, I_GU = 16 * 176, I_DN = 44 * 32, I_L = I_IN + I_OUT + I_GU + I_DN;
    for (int it0 = launder_bid() * 8; it0 < NL * I_L; it0 += launder_gdim() * 8) {
        const int it = it0 + wave; const bool on = it < NL * I_L;
        const int l = it / I_L; int r = it % I_L; int kind = 0;
        if (r >= I_IN) { r -= I_IN; kind = 1; if (r >= I_OUT) { r -= I_OUT; kind = 2; if (r >= I_GU) { r -= I_GU; kind = 3; } } }
        if (on) {
            if (kind == 0) cvt_load<0>(P.in[I_WIN] + (size_t)l * DM * NINSRC, nullptr, NINSRC, P.in[I_LN1] + l * DM, scr, r, 56, lane);
            else if (kind == 1) cvt_load<1>(P.in[I_WOUT] + (size_t)l * DM * DM, nullptr, DM, nullptr, scr, r, 32, lane);
            else if (kind == 2) cvt_load<2>(P.in[I_WG] + (size_t)l * DM * FFN, P.in[I_WU] + (size_t)l * DM * FFN, FFN, P.in[I_LN2] + l * DM, scr, r, 176, lane);
            else cvt_load<1>(P.in[I_WD] + (size_t)l * FFN * DM, nullptr, DM, nullptr, scr, r, 32, lane);
        }
        LDS_WAIT(); __syncthreads();
        if (on) {
            if (kind == 0) cvt_store(DM, (bf16_t*)(ws + WS_WIN) + (size_t)l * NIN * DM, scr, r, 56, lane);
            else if (kind == 1) cvt_store(DM, (bf16_t*)(ws + WS_WOUT) + (size_t)l * DM * DM, scr, r, 32, lane);
            else if (kind == 2) cvt_store(DM, (bf16_t*)(ws + WS_WGU) + (size_t)l * NGU * DM, scr, r, 176, lane);
            else cvt_store(FFN, (bf16_t*)(ws + WS_WDN) + (size_t)l * DM * FFN, scr, r, 32, lane);
        }
        LDS_WAIT(); __syncthreads();
    }
    {
        float* XF = (float*)(ws + WS_XF); bf16_t* XB = (bf16_t*)(ws + WS_XB); float* ssq = (float*)(ws + WS_SSQ);
        for (int r = gw; r < MR; r += NGW) {
            const float* src = nullptr;
            if (r < R_META) src = P.in[I_XP] + (size_t)r * DM;
            else if (r < R_SAMP) src = P.in[I_META] + (size_t)((r - R_META) & 15) * DM;
            else if (r < R_VALID) src = P.in[I_XS] + (size_t)(r - R_SAMP) * DM;
            float s = 0.f;
#pragma unroll
            for (int j = 0; j < 4; ++j) {
                f32x4 v = {0.f, 0.f, 0.f, 0.f};
                if (src) v = *(const f32x4*)(src + 256 * j + 4 * lane);
                *(f32x4*)(XF + (size_t)r * DM + 256 * j + 4 * lane) = v;
                u32x2 w; w.x = pk2(v.x, v.y); w.y = pk2(v.z, v.w);
                *(u32x2*)(XB + (size_t)r * DM + 256 * j + 4 * lane) = w;
                s += (v.x * v.x + v.y * v.y) + (v.z * v.z + v.w * v.w);
            }
            s = wave_sum(s);
            if (lane < 4) ssq[(size_t)lane * MR + r] = lane == 0 ? s : 0.f;
        }
    }
    {
        bf16_t* MIX = (bf16_t*)(ws + WS_MIX);
        #ifdef DBG_RT
        for (int i = gt; i < MR * DM / 8; i += NGT) { u32x4 z = {0u, 0u, 0u, 0u}; *(u32x4*)(MIX + (size_t)i * 8) = z; }
#else
        for (int i = gt; i < (MR - R_VALID) * DM / 8; i += NGT) { u32x4 z = {0u, 0u, 0u, 0u}; *(u32x4*)(MIX + (size_t)R_VALID * DM + (size_t)i * 8) = z; }
#endif
    }
    {
        float* rc = (float*)(ws + TAB_ROPEC); float* rsn = (float*)(ws + TAB_ROPES);
        for (int i = gt; i < TT * 32; i += NGT) { const int pos = i >> 5, d = i & 31; float s, c; sincos_red((double)pos * ROPE_INV[d], s, c); rc[i] = c; rsn[i] = s; }
    }
    {
        float* ABAR = (float*)(ws + TAB_ABAR); float* A64 = (float*)(ws + TAB_A64); float* BBF = (float*)(ws + TAB_BBF);
        bf16_t* BBP = (bf16_t*)(ws + TAB_BBP); bf16_t* CC = (bf16_t*)(ws + TAB_CC);
        for (int i = gt; i < NL * 16 * 64; i += NGT) {
            const int l = i >> 10, g = (i >> 6) & 15, n = i & 63;
            const float dt = __expf(P.in[I_LOGDT][l * 16 + g]);
            const float ar = P.in[I_ARE][i], ai = P.in[I_AIM][i];
            const float mag = __expf(dt * ar);
            float sn, cs; sincos_red((double)dt * (double)ai, sn, cs);
            const float abr = mag * cs, abi = mag * sn;
            ABAR[2 * i] = abr; ABAR[2 * i + 1] = abi;
            const float mag64 = __expf(64.f * dt * ar);
            float s64, c64; sincos_red(64.0 * (double)dt * (double)ai, s64, c64);
            A64[2 * i] = mag64 * c64; A64[2 * i + 1] = mag64 * s64;
            const float den = ar * ar + ai * ai, xr = abr - 1.0f;
            const float fre = (xr * ar + abi * ai) / den, fim = (abi * ar - xr * ai) / den;
            const int gp = g >> 1, gi = g & 1;
            bf16_t* bp_re = BBP + (((size_t)l * 8 + gp) * 256 + 128 * gi + n) * 32;
            bf16_t* bp_im = bp_re + 64 * 32;
#pragma unroll
            for (int c = 0; c < 16; ++c) {
                const float br = P.in[I_BRE][(size_t)i * 16 + c], bi = P.in[I_BIM][(size_t)i * 16 + c];
                const float bbr = fre * br - fim * bi, bbi = fre * bi + fim * br;
                BBF[(size_t)i * 32 + c] = bbr; BBF[(size_t)i * 32 + 16 + c] = bbi;
                bp_re[16 * gi + c] = (bf16_t)f2bf(bbr); bp_im[16 * gi + c] = (bf16_t)f2bf(bbi);
                bp_re[16 * (1 - gi) + c] = 0; bp_im[16 * (1 - gi) + c] = 0;
            }
        }
        for (int i = gt; i < NL * 16 * 16 * 128; i += NGT) {
            const int k = i & 127, lgc = i >> 7;
            const float v = k < 64 ? P.in[I_CRE][(size_t)lgc * 64 + k] : -P.in[I_CIM][(size_t)lgc * 64 + (k - 64)];
            CC[i] = (bf16_t)f2bf(v);
        }
        bf16_t* GLUT = (bf16_t*)(ws + TAB_GLUT);
        for (int i = gt; i < NL * 256 * 256; i += NGT) {
            const int k = i & 255, n = (i >> 8) & 255, l = i >> 16;
            GLUT[i] = (bf16_t)f2bf(P.in[I_GLUW][((size_t)l * 256 + k) * 256 + n]);
        }
        float* WDT = (float*)(ws + TAB_WDT);
        for (int i = gt; i < NL * 4 * DM; i += NGT) {
            const int k = i & 1023, j = (i >> 10) & 3, l = i >> 12;
            WDT[i] = P.in[I_WIN][((size_t)l * DM + k) * NINSRC + NIN + j] * P.in[I_LN1][l * DM + k];
        }
    }
}

__device__ __forceinline__ void zero_pads(const Params& P, int l) {
    unsigned char* ws = P.ws;
    const int gt = launder_bid() * 512 + launder_tid(), NGT = launder_gdim() * 512;
    bf16_t* Kb = (bf16_t*)(ws + WS_K); bf16_t* Vt = (bf16_t*)(ws + WS_VT); float* U = (float*)(ws + ws_u_off(l)); bf16_t* XBCb = (bf16_t*)(ws + WS_XBC);
    for (int i = gt; i < 2 * 112 * 128; i += NGT) { const int c = i & 127, rr = i >> 7, b = rr / 112, lq = rr % 112, pr = b * BPAD + lq; Kb[(size_t)pr * 128 + c] = 0; Vt[(size_t)c * PR + pr] = 0; }
    for (int i = gt; i < 2 * 112 * 256; i += NGT) { const int c = i & 255, rr = i >> 8, b = rr / 112, lq = rr % 112, pr = b * BPAD + lq; U[(size_t)pr * 256 + c] = 0.f; }
    for (int i = gt; i < 2 * 112 * 512; i += NGT) { const int c = i & 511, rr = i >> 9, b = rr / 112, lq = rr % 112, pr = b * BPAD + lq; XBCb[(size_t)pr * 512 + c] = 0; }
}

__device__ __forceinline__ void dt_rows(const Params& P, int l) {
    const int lane = launder_tid() & 63, gw = launder_bid() * 8 + (launder_tid() >> 6), NGW = launder_gdim() * 8;
    const bf16_t* XB = (const bf16_t*)(P.ws + WS_XB); const float* ssq = (const float*)(P.ws + WS_SSQ);
    const float* WDT = (const float*)(P.ws + TAB_WDT) + (size_t)l * 4 * DM; float* DT = (float*)(P.ws + WS_DT);
    for (int r = gw; r < R_VALID; r += NGW) {
        int pos; const int pr = row_to_pr(r, pos);
        const u32x4 a = *(const u32x4*)(XB + (size_t)r * DM + 16 * lane), b = *(const u32x4*)(XB + (size_t)r * DM + 16 * lane + 8);
        float x[16] = {bflo(a.x), bfhi(a.x), bflo(a.y), bfhi(a.y), bflo(a.z), bfhi(a.z), bflo(a.w), bfhi(a.w),
                       bflo(b.x), bfhi(b.x), bflo(b.y), bfhi(b.y), bflo(b.z), bfhi(b.z), bflo(b.w), bfhi(b.w)};
        float d[4];
#pragma unroll
        for (int j = 0; j < 4; ++j) {
            const float* wv = WDT + j * DM + 16 * lane; float s = 0.f;
#pragma unroll
            for (int q = 0; q < 4; ++q) { const f32x4 w = *(const f32x4*)(wv + 4 * q); s += x[4 * q] * w.x + x[4 * q + 1] * w.y + x[4 * q + 2] * w.z + x[4 * q + 3] * w.w; }
            d[j] = wave_sum(s);
        }
        const float rs = row_rs(ssq, r);
        if (lane == 0) { f32x4 o = {d[0] * rs, d[1] * rs, d[2] * rs, d[3] * rs}; *(f32x4*)(DT + (size_t)pr * 4) = o; }
    }
}

__device__ __forceinline__ void attn_prompt_unit(const Params& P, int l, int b, int blk, LAS unsigned char* lds) {
    const int tid = launder_tid(), w = __builtin_amdgcn_readfirstlane(tid >> 6), lane = tid & 63, q = lane & 31, hh = lane >> 5;
    const int rt = w >> 1, kvh = w & 1;
    const int lq0 = blk * 128 + rt * 32, prq0 = b * BPAD + lq0;
    const bf16_t* Q = (const bf16_t*)(P.ws + WS_Q); const bf16_t* Kb = (const bf16_t*)(P.ws + WS_K); const bf16_t* Vt = (const bf16_t*)(P.ws + WS_VT);
    LAS bf16_t* ob = (LAS bf16_t*)(lds + w * 16896);
    LAS float* ssx = (LAS float*)(lds + 8 * 16896);
    float ssq_acc = 0.f;
    const int tq = lq0 + q - 112;
    for (int hq = 0; hq < 4; ++hq) {
        const int head = kvh * 4 + hq;
        bf16x8 qf[4];
#pragma unroll
        for (int ks = 0; ks < 4; ++ks) qf[ks] = *(const bf16x8*)(Q + (size_t)(prq0 + q) * 512 + head * 64 + ks * 16 + hh * 8);
        f32x16 S[5];
#pragma unroll
        for (int kt = 0; kt < 5; ++kt) {
            int prk = prq0 - 128 + kt * 32 + q; prk = prk < 0 ? 0 : prk;
            f32x16 a;
#pragma unroll
            for (int e = 0; e < 16; ++e) a[e] = 0.f;
#pragma unroll
            for (int ks = 0; ks < 4; ++ks) { const bf16x8 kf = *(const bf16x8*)(Kb + (size_t)prk * 128 + kvh * 64 + ks * 16 + hh * 8); a = MFMA32(kf, qf[ks], a); }
            S[kt] = a;
            asm volatile("" ::: "memory");
        }
        float mx = -INFINITY;
#pragma unroll
        for (int kt = 0; kt < 5; ++kt)
#pragma unroll
            for (int e = 0; e < 16; ++e) {
                const int tk = lq0 - 128 + kt * 32 + (e & 3) + 8 * (e >> 2) + 4 * hh - 112;
                const bool ok = (tk >= 0) && (tk <= tq) && (tq - tk <= 128);
                const float s = ok ? S[kt][e] * 0.125f : -INFINITY;
                S[kt][e] = s; mx = fmaxf(mx, s);
            }
        mx = fmaxf(mx, __shfl_xor(mx, 32));
        const float sink = P.in[I_SINK][l * 8 + head];
        const float mfin = fmaxf(mx, sink);
        float sum = 0.f;
#pragma unroll
        for (int kt = 0; kt < 5; ++kt)
#pragma unroll
            for (int e = 0; e < 16; ++e) { const float p = __expf(S[kt][e] - mfin); S[kt][e] = p; sum += p; }
        sum += __shfl_xor(sum, 32);
        const float inv = 1.0f / (sum + __expf(sink - mfin));
        f32x16 O0, O1;
#pragma unroll
        for (int e = 0; e < 16; ++e) { O0[e] = 0.f; O1[e] = 0.f; }
#pragma unroll
        for (int kt = 0; kt < 5; ++kt)
#pragma unroll
            for (int s2 = 0; s2 < 2; ++s2) {
                u32x4 pw; pw.x = pk2(S[kt][8 * s2 + 0], S[kt][8 * s2 + 1]); pw.y = pk2(S[kt][8 * s2 + 2], S[kt][8 * s2 + 3]);
                pw.z = pk2(S[kt][8 * s2 + 4], S[kt][8 * s2 + 5]); pw.w = pk2(S[kt][8 * s2 + 6], S[kt][8 * s2 + 7]);
                const bf16x8 pf = __builtin_bit_cast(bf16x8, pw);
                int k0 = prq0 - 128 + kt * 32 + 16 * s2 + 4 * hh, k1 = k0 + 8;
                k0 = k0 < 0 ? 0 : k0; k1 = k1 < 0 ? 0 : k1;
                const bf16_t* v0 = Vt + (size_t)(kvh * 64 + q) * PR;
                const bf16_t* v1 = Vt + (size_t)(kvh * 64 + 32 + q) * PR;
                u32x4 a0, a1; const u32x2 x0 = *(const u32x2*)(v0 + k0), x1 = *(const u32x2*)(v0 + k1), y0 = *(const u32x2*)(v1 + k0), y1 = *(const u32x2*)(v1 + k1);
                a0.x = x0.x; a0.y = x0.y; a0.z = x1.x; a0.w = x1.y; a1.x = y0.x; a1.y = y0.y; a1.z = y1.x; a1.w = y1.y;
                O0 = MFMA32(__builtin_bit_cast(bf16x8, a0), pf, O0);
                O1 = MFMA32(__builtin_bit_cast(bf16x8, a1), pf, O1);
                asm volatile("" ::: "memory");
            }
        float qs = 0.f;
#pragma unroll
        for (int e = 0; e < 16; ++e) { O0[e] *= inv; O1[e] *= inv; qs += O0[e] * O0[e] + O1[e] * O1[e]; }
        qs += __shfl_xor(qs, 32);
        ssq_acc += qs;
#pragma unroll
        for (int g4 = 0; g4 < 4; ++g4) {
            u32x2 w0, w1; w0.x = pk2(O0[4 * g4], O0[4 * g4 + 1]); w0.y = pk2(O0[4 * g4 + 2], O0[4 * g4 + 3]); w1.x = pk2(O1[4 * g4], O1[4 * g4 + 1]); w1.y = pk2(O1[4 * g4 + 2], O1[4 * g4 + 3]);
            *(LAS u32x2*)(ob + q * 264 + hq * 64 + 8 * g4 + 4 * hh) = w0;
            *(LAS u32x2*)(ob + q * 264 + hq * 64 + 32 + 8 * g4 + 4 * hh) = w1;
        }
    }
    if (hh == 0) ssx[(rt * 2 + kvh) * 32 + q] = ssq_acc;
    LDS_WAIT(); __syncthreads();
    bf16_t* MIX = (bf16_t*)(P.ws + WS_MIX); const float* gain = P.in[I_ATTG] + l * 512 + kvh * 256;
#pragma unroll 4
    for (int it = 0; it < 16; ++it) {
        const int chunk = it * 64 + lane, row = chunk >> 5, cc = chunk & 31;
        const int r = pr_to_row(prq0 + row);
        const float tot = ssx[(rt * 2) * 32 + row] + ssx[(rt * 2 + 1) * 32 + row];
        const float rs = rsqrtf(tot * (1.0f / 512.0f) + EPS);
        const u32x4 v = *(const LAS u32x4*)(ob + row * 264 + cc * 8);
        const f32x4 g0 = *(const f32x4*)(gain + cc * 8), g1 = *(const f32x4*)(gain + cc * 8 + 4);
        u32x4 o; o.x = pk2(bflo(v.x) * rs * g0.x, bfhi(v.x) * rs * g0.y); o.y = pk2(bflo(v.y) * rs * g0.z, bfhi(v.y) * rs * g0.w);
        o.z = pk2(bflo(v.z) * rs * g1.x, bfhi(v.z) * rs * g1.y); o.w = pk2(bflo(v.w) * rs * g1.z, bfhi(v.w) * rs * g1.w);
        if (r >= 0) *(u32x4*)(MIX + (size_t)r * DM + kvh * 256 + cc * 8) = o;
    }
    __syncthreads();
}

__device__ __forceinline__ void attn_sample_unit(const Params& P, int l, int i, LAS unsigned char* lds) {
    const int tid = launder_tid(), w = __builtin_amdgcn_readfirstlane(tid >> 6), lane = tid & 63, kvh = w >> 2;
    const int pr = PR_SAMP + i;
    const bf16_t* Q = (const bf16_t*)(P.ws + WS_Q) + (size_t)pr * 512 + w * 64;
    float qv[64];
#pragma unroll
    for (int c = 0; c < 8; ++c) { const u32x4 v = *(const u32x4*)(Q + 8 * c); qv[8 * c] = bflo(v.x); qv[8 * c + 1] = bfhi(v.x); qv[8 * c + 2] = bflo(v.y); qv[8 * c + 3] = bfhi(v.y);
        qv[8 * c + 4] = bflo(v.z); qv[8 * c + 5] = bfhi(v.z); qv[8 * c + 6] = bflo(v.w); qv[8 * c + 7] = bfhi(v.w); }
    const float* ck = P.in[I_CK] + (((size_t)l * 128 + i) * 128) * 128 + kvh * 64;
    const float* cv = P.in[I_CV] + (((size_t)l * 128 + i) * 128) * 128 + kvh * 64;
    float s0 = 0.f, s1 = 0.f, sn = 0.f;
#pragma unroll
    for (int c = 0; c < 16; ++c) {
        const f32x4 a = *(const f32x4*)(ck + (size_t)lane * 128 + 4 * c), b2 = *(const f32x4*)(ck + (size_t)(lane + 64) * 128 + 4 * c);
        s0 += qv[4 * c] * a.x + qv[4 * c + 1] * a.y + qv[4 * c + 2] * a.z + qv[4 * c + 3] * a.w;
        s1 += qv[4 * c] * b2.x + qv[4 * c + 1] * b2.y + qv[4 * c + 2] * b2.z + qv[4 * c + 3] * b2.w;
    }
    {
        const bf16_t* kn = (const bf16_t*)(P.ws + WS_K) + (size_t)pr * 128 + kvh * 64;
#pragma unroll
        for (int c = 0; c < 8; ++c) { const u32x4 v = *(const u32x4*)(kn + 8 * c);
            sn += qv[8 * c] * bflo(v.x) + qv[8 * c + 1] * bfhi(v.x) + qv[8 * c + 2] * bflo(v.y) + qv[8 * c + 3] * bfhi(v.y) + qv[8 * c + 4] * bflo(v.z) + qv[8 * c + 5] * bfhi(v.z) + qv[8 * c + 6] * bflo(v.w) + qv[8 * c + 7] * bfhi(v.w); }
    }
    s0 *= 0.125f; s1 *= 0.125f; sn *= 0.125f;
    const float sink = P.in[I_SINK][l * 8 + w];
    const float m = fmaxf(wave_max(fmaxf(fmaxf(s0, s1), sn)), sink);
    const float p0 = __expf(s0 - m), p1 = __expf(s1 - m), pn = __expf(sn - m);
    const float den = wave_sum(p0 + p1) + pn + __expf(sink - m);
    float o = 0.f;
#pragma unroll 16
    for (int j = 0; j < 64; ++j) { const float pj = __shfl(p0, j); o += pj * cv[(size_t)j * 128 + lane]; }
#pragma unroll 16
    for (int j = 0; j < 64; ++j) { const float pj = __shfl(p1, j); o += pj * cv[(size_t)(j + 64) * 128 + lane]; }
    const bf16_t* Vt = (const bf16_t*)(P.ws + WS_VT);
    o += pn * bf2f(Vt[(size_t)(kvh * 64 + lane) * PR + pr]);
    o /= den;
    LAS float* ssx = (LAS float*)lds;
    const float qs = wave_sum(o * o);
    if (lane == 0) ssx[w] = qs;
    LDS_WAIT(); __syncthreads();
    float tot = 0.f;
#pragma unroll
    for (int k = 0; k < 8; ++k) tot += ssx[k];
    const float rs = rsqrtf(tot * (1.0f / 512.0f) + EPS);
    bf16_t* MIX = (bf16_t*)(P.ws + WS_MIX);
    MIX[(size_t)(R_SAMP + i) * DM + w * 64 + lane] = (bf16_t)f2bf(o * rs * P.in[I_ATTG][l * 512 + w * 64 + lane]);
    const float* cks = P.in[I_CK] + (((size_t)l * 128 + i) * 128 + 1) * 128; const float* cvs = P.in[I_CV] + (((size_t)l * 128 + i) * 128 + 1) * 128;
    float* oks = P.out + O_KS + (((size_t)l * 128 + i) * 128) * 128; float* ovs = P.out + O_VS + (((size_t)l * 128 + i) * 128) * 128;
    for (int x = tid; x < 127 * 32; x += 512) { *(f32x4*)(oks + 4 * x) = *(const f32x4*)(cks + 4 * x); *(f32x4*)(ovs + 4 * x) = *(const f32x4*)(cvs + 4 * x); }
    __syncthreads();
}

#define S5_EXTRA_SYNC() __syncthreads()
template <bool OUT>
__device__ __forceinline__ void s5_unit(const Params& P, int l, int b, int c, LAS unsigned char* lds) {
    const int tid = launder_tid(), w = __builtin_amdgcn_readfirstlane(tid >> 6), lane = tid & 63, fr = lane & 15, fq = lane >> 4;
    const int pr0 = b * BPAD + 64 * c;
    LAS float* bu = (LAS float*)(lds + w * 12800);
    LAS bf16_t* hb = (LAS bf16_t*)(lds + w * 12800 + 8448);
    LAS bf16_t* y5 = (LAS bf16_t*)(lds + 102400);
    LAS float* ssx = (LAS float*)(lds + 102400 + 33792);
    const float* U = (const float*)(P.ws + ws_u_off(l));
    const bf16_t* BBP = (const bf16_t*)(P.ws + TAB_BBP); const bf16_t* CC = (const bf16_t*)(P.ws + TAB_CC);
    const float* ABAR = (const float*)(P.ws + TAB_ABAR);
    for (int gi = 0; gi < 2; ++gi) {
        const int g = 2 * w + gi;
        bf16x8 bbf[8];
#pragma unroll
        for (int nt = 0; nt < 8; ++nt) bbf[nt] = *(const bf16x8*)(BBP + (((size_t)l * 8 + w) * 256 + 128 * gi + 16 * nt + fr) * 32 + 8 * fq);
        bf16x8 ccf[4];
        if (OUT) {
#pragma unroll
            for (int ks = 0; ks < 4; ++ks) ccf[ks] = *(const bf16x8*)(CC + (((size_t)l * 16 + g) * 16 + fr) * 128 + 32 * ks + 8 * fq);
        }
        const size_t sidx = (((size_t)l * 16 + g) * 64 + lane) * 2;
        const float ar = ABAR[sidx], ai = ABAR[sidx + 1];
        const size_t eidx = ((((size_t)b * NCH5 + c) * 16 + g) * 64 + lane) * 2;
        float hr = 0.f, hi = 0.f;
#ifndef DBG_S5C
        if (OUT) { float* H0 = (float*)(P.ws + WS_H05);
#ifdef DBG_S5D
            hr = __hip_atomic_load(H0 + eidx, __ATOMIC_RELAXED, __HIP_MEMORY_SCOPE_AGENT); hi = __hip_atomic_load(H0 + eidx + 1, __ATOMIC_RELAXED, __HIP_MEMORY_SCOPE_AGENT);
#else
            hr = H0[eidx]; hi = H0[eidx + 1];
#endif
        }
#endif
        const float dd = OUT ? P.in[I_S5D][l * 256 + 16 * g + fr] : 0.f;
        for (int sb = 0; sb < 4; ++sb) {
            const bf16x8 uf = ld_bf16x8_f32(U + (size_t)(pr0 + 16 * sb + fr) * 256 + 32 * w + 8 * fq);
#pragma unroll
            for (int nt = 0; nt < 8; ++nt) {
                f32x4 z = {0.f, 0.f, 0.f, 0.f};
                f32x4 d = MFMA16(uf, bbf[nt], z);
#pragma unroll
                for (int e = 0; e < 4; ++e) bu[(4 * fq + e) * 132 + 16 * nt + fr] = d[e];
            }
            LDS_WAIT(); asm volatile("" ::: "memory"); S5_EXTRA_SYNC();
#pragma unroll
            for (int tok = 0; tok < 16; ++tok) {
                const float bre = bu[tok * 132 + lane], bim = bu[tok * 132 + 64 + lane];
                const float nr = ar * hr - ai * hi + bre, ni = ar * hi + ai * hr + bim;
                hr = nr; hi = ni;
                if (OUT) { hb[tok * 136 + lane] = (bf16_t)f2bf(hr); hb[tok * 136 + 64 + lane] = (bf16_t)f2bf(hi); }
            }
            LDS_WAIT(); asm volatile("" ::: "memory"); S5_EXTRA_SYNC();
            if (OUT) {
                f32x4 y = {0.f, 0.f, 0.f, 0.f};
#pragma unroll
                for (int ks = 0; ks < 4; ++ks) { const bf16x8 hf = *(const LAS bf16x8*)(hb + fr * 136 + 32 * ks + 8 * fq); y = MFMA16(hf, ccf[ks], y); }

#pragma unroll
                for (int e = 0; e < 4; ++e) {
                    const int tok = 16 * sb + 4 * fq + e;
                    const float uu = U[(size_t)(pr0 + tok) * 256 + 16 * g + fr];
#ifdef DBG_S5A
                    y5[tok * 264 + 16 * g + fr] = (bf16_t)f2bf(gelu_tanh(0.f * y[e] + dd * uu));
#else
                    y5[tok * 264 + 16 * g + fr] = (bf16_t)f2bf(gelu_tanh(y[e] + dd * uu));
#endif
                }
                LDS_WAIT(); asm volatile("" ::: "memory"); S5_EXTRA_SYNC();
            }
        }
        if (!OUT) { float* E5 = (float*)(P.ws + ws_e5_off(l));
#ifdef DBG_S5D
            __hip_atomic_store(E5 + eidx, hr, __ATOMIC_RELAXED, __HIP_MEMORY_SCOPE_AGENT); __hip_atomic_store(E5 + eidx + 1, hi, __ATOMIC_RELAXED, __HIP_MEMORY_SCOPE_AGENT);
#else
            E5[eidx] = hr; E5[eidx + 1] = hi;
#endif
        }
    }
    if (!OUT) { __syncthreads(); return; }
    __syncthreads();
    const bf16_t* GLUT = (const bf16_t*)(P.ws + TAB_GLUT) + (size_t)l * 65536;
    f32x4 ga[4][2];
#pragma unroll
    for (int mt = 0; mt < 4; ++mt)
#pragma unroll
        for (int j = 0; j < 2; ++j) ga[mt][j] = (f32x4){0.f, 0.f, 0.f, 0.f};
#pragma unroll 2
    for (int ks = 0; ks < 8; ++ks) {
        bf16x8 bfr[2];
#pragma unroll
        for (int j = 0; j < 2; ++j) bfr[j] = *(const bf16x8*)(GLUT + (size_t)(32 * w + 16 * j + fr) * 256 + 32 * ks + 8 * fq);
#pragma unroll
        for (int mt = 0; mt < 4; ++mt) {
            const bf16x8 af = *(const LAS bf16x8*)(y5 + (16 * mt + fr) * 264 + 32 * ks + 8 * fq);
#pragma unroll
            for (int j = 0; j < 2; ++j) ga[mt][j] = MFMA16(af, bfr[j], ga[mt][j]);
        }
    }
#pragma unroll
    for (int mt = 0; mt < 4; ++mt) {
        float part[4] = {0.f, 0.f, 0.f, 0.f};
#pragma unroll
        for (int j = 0; j < 2; ++j) {
            const int n = 32 * w + 16 * j + fr; const float gb = P.in[I_GLUB][l * 256 + n];
#pragma unroll
            for (int e = 0; e < 4; ++e) {
                const int tok = 16 * mt + 4 * fq + e;
#ifdef DBG_S5B
                const float v = bf2f(y5[tok * 264 + n]) * sigmoidf_(0.f * ga[mt][j][e] + gb);
#else
                const float v = bf2f(y5[tok * 264 + n]) * sigmoidf_(ga[mt][j][e] + gb);
#endif
                ga[mt][j][e] = v; part[e] += v * v;
            }
        }
#pragma unroll
        for (int e = 0; e < 4; ++e) {
            float p = part[e]; p += __shfl_xor(p, 1); p += __shfl_xor(p, 2); p += __shfl_xor(p, 4); p += __shfl_xor(p, 8);
            if (fr == 0) ssx[(16 * mt + 4 * fq + e) * 8 + w] = p;
        }
    }
    LDS_WAIT(); __syncthreads();
#pragma unroll
    for (int mt = 0; mt < 4; ++mt)
#pragma unroll
        for (int j = 0; j < 2; ++j)
#pragma unroll
            for (int e = 0; e < 4; ++e) y5[(16 * mt + 4 * fq + e) * 264 + 32 * w + 16 * j + fr] = (bf16_t)f2bf(ga[mt][j][e]);
    LDS_WAIT(); __syncthreads();
    bf16_t* MIX = (bf16_t*)(P.ws + WS_MIX); const float* gain = P.in[I_S5G] + l * 256;
#pragma unroll
    for (int it = 0; it < 4; ++it) {
        const int chunk = it * 512 + tid, row = chunk >> 5, cc = chunk & 31;
        const int r = pr_to_row(pr0 + row);
        const f32x4 t0 = *(const LAS f32x4*)(ssx + row * 8), t1 = *(const LAS f32x4*)(ssx + row * 8 + 4);
        const float tot = ((t0.x + t0.y) + (t0.z + t0.w)) + ((t1.x + t1.y) + (t1.z + t1.w));
        const float rs = rsqrtf(tot * (1.0f / 256.0f) + EPS);
        const u32x4 v = *(const LAS u32x4*)(y5 + row * 264 + cc * 8);
        const f32x4 g0 = *(const f32x4*)(gain + cc * 8), g1 = *(const f32x4*)(gain + cc * 8 + 4);
        u32x4 o; o.x = pk2(bflo(v.x) * rs * g0.x, bfhi(v.x) * rs * g0.y); o.y = pk2(bflo(v.y) * rs * g0.z, bfhi(v.y) * rs * g0.w);
        o.z = pk2(bflo(v.z) * rs * g1.x, bfhi(v.z) * rs * g1.y); o.w = pk2(bflo(v.w) * rs * g1.z, bfhi(v.w) * rs * g1.w);
        if (r >= 0) *(u32x4*)(MIX + (size_t)r * DM + 512 + cc * 8) = o;
    }
    __syncthreads();
}

__device__ __forceinline__ void s5_sample_unit(const Params& P, int l, int i, LAS unsigned char* lds) {
    const int tid = launder_tid(), pr = PR_SAMP + i;
    LAS float* hsr = (LAS float*)lds;
    LAS float* hsi = hsr + 1024;
    LAS float* us = hsi + 1024;
    LAS float* ys = us + 256;
    LAS float* red = ys + 256;
    const float* U = (const float*)(P.ws + ws_u_off(l)) + (size_t)pr * 256;
    if (tid < 256) us[tid] = U[tid];
    LDS_WAIT(); __syncthreads();
    const float* ABAR = (const float*)(P.ws + TAB_ABAR); const float* BBF = (const float*)(P.ws + TAB_BBF);
#pragma unroll
    for (int rep = 0; rep < 2; ++rep) {
        const int idx = tid + 512 * rep, g = idx >> 6;
        const size_t si = (size_t)l * 1024 + idx;
        const float ar = ABAR[2 * si], ai = ABAR[2 * si + 1];
        const size_t st = ((size_t)l * 128 + i) * 1024 + idx;
        const float h0r = P.in[I_S5R][st], h0i = P.in[I_S5I][st];
        float br = 0.f, bi = 0.f;
#pragma unroll
        for (int cch = 0; cch < 16; ++cch) { const float uu = us[16 * g + cch]; br += BBF[si * 32 + cch] * uu; bi += BBF[si * 32 + 16 + cch] * uu; }
        const float hr = ar * h0r - ai * h0i + br, hi = ar * h0i + ai * h0r + bi;
        P.out[O_S5RS + st] = hr; P.out[O_S5IS + st] = hi;
        hsr[idx] = hr; hsi[idx] = hi;
    }
    LDS_WAIT(); __syncthreads();
    if (tid < 256) {
        const int g = tid >> 4;
        const float* cr = P.in[I_CRE] + ((size_t)l * 256 + tid) * 64; const float* ci = P.in[I_CIM] + ((size_t)l * 256 + tid) * 64;
        float y = 0.f;
#pragma unroll 8
        for (int n = 0; n < 64; ++n) y += cr[n] * hsr[64 * g + n] - ci[n] * hsi[64 * g + n];
        y += P.in[I_S5D][l * 256 + tid] * us[tid];
        ys[tid] = gelu_tanh(y);
    }
    LDS_WAIT(); __syncthreads();
    float v = 0.f;
    if (tid < 256) {
        const float* gw = P.in[I_GLUW] + (size_t)l * 65536 + tid; float z = P.in[I_GLUB][l * 256 + tid];
#pragma unroll 8
        for (int k = 0; k < 256; ++k) z += ys[k] * gw[(size_t)k * 256];
        v = ys[tid] * sigmoidf_(z);
    }
    const float qs = wave_sum(v * v);
    if ((tid & 63) == 0) red[tid >> 6] = qs;
    LDS_WAIT(); __syncthreads();
    const float tot = (red[0] + red[1]) + (red[2] + red[3]);
    const float rs = rsqrtf(tot * (1.0f / 256.0f) + EPS);
    if (tid < 256) ((bf16_t*)(P.ws + WS_MIX))[(size_t)(R_SAMP + i) * DM + 512 + tid] = (bf16_t)f2bf(v * rs * P.in[I_S5G][l * 256 + tid]);
    __syncthreads();
}

__device__ __forceinline__ void ssd_local_unit(const Params& P, int l, int b, int c, LAS unsigned char* lds) {
    const int tid = launder_tid(), w = __builtin_amdgcn_readfirstlane(tid >> 6), lane = tid & 63, fr = lane & 15, fq = lane >> 4;
    const int pr0 = b * BPAD + 128 * c;
    LAS bf16_t* xwT = (LAS bf16_t*)lds;
    LAS bf16_t* bmT = (LAS bf16_t*)(lds + 69632);
    LAS float* dts = (LAS float*)(lds + 104448);
    LAS float* cs = (LAS float*)(lds + 106496);
    {
        const int j = tid >> 2, h = tid & 3, t = 128 * c + j - 112;
        float v = 0.f;
        if (t >= 0) v = softplusf_(((const float*)(P.ws + WS_DT))[(size_t)(pr0 + j) * 4 + h] + P.in[I_DTB][l * 4 + h]);
        dts[tid] = v; ((float*)(P.ws + WS_DTS))[(size_t)pr0 * 4 + tid] = v;
    }
    LDS_WAIT(); __syncthreads();
    if (w < 4) {
        const int h = w; const float A = -__expf(P.in[I_ALOG][l * 4 + h]);
        const float a0 = dts[(2 * lane) * 4 + h] * A, a1 = dts[(2 * lane + 1) * 4 + h] * A;
        float s = a0 + a1;
#pragma unroll
        for (int off = 1; off < 64; off <<= 1) { const float v = __shfl_up(s, off); if (lane >= off) s += v; }
        cs[(2 * lane + 1) * 4 + h] = s; cs[(2 * lane) * 4 + h] = s - a1;
        float* CS = (float*)(P.ws + WS_CS) + (size_t)pr0 * 4;
        CS[(2 * lane + 1) * 4 + h] = s; CS[(2 * lane) * 4 + h] = s - a1;
    }
    LDS_WAIT(); __syncthreads();
    {
        const int ch = tid, h = (ch >> 6) & 3;
        const float w0 = P.in[I_CONVW][(l * 4 + 0) * 512 + ch], w1 = P.in[I_CONVW][(l * 4 + 1) * 512 + ch], w2 = P.in[I_CONVW][(l * 4 + 2) * 512 + ch], w3 = P.in[I_CONVW][(l * 4 + 3) * 512 + ch];
        const float bias = P.in[I_CONVB][l * 512 + ch];
        const bf16_t* XBCb = (const bf16_t*)(P.ws + WS_XBC); bf16_t* XC = (bf16_t*)(P.ws + WS_XC);
        float x0 = 0.f, x1 = 0.f, x2 = 0.f;
        if (c > 0) { x0 = bf2f(XBCb[(size_t)(pr0 - 3) * 512 + ch]); x1 = bf2f(XBCb[(size_t)(pr0 - 2) * 512 + ch]); x2 = bf2f(XBCb[(size_t)(pr0 - 1) * 512 + ch]); }
        const float cl = cs[127 * 4 + h];
#pragma unroll 4
        for (int j = 0; j < 128; ++j) {
            const float xn = bf2f(XBCb[(size_t)(pr0 + j) * 512 + ch]);
            const float v = bias + w0 * x0 + w1 * x1 + w2 * x2 + w3 * xn;
            x0 = x1; x1 = x2; x2 = xn;
            const float xc = (128 * c + j - 112 >= 0) ? siluf_(v) : 0.f;
            XC[(size_t)(pr0 + j) * 512 + ch] = (bf16_t)f2bf(xc);
            if (ch < 256) { const float sc = dts[j * 4 + h] * __expf(cl - cs[j * 4 + h]); xwT[ch * 136 + j] = (bf16_t)f2bf(xc * sc); }
            else if (ch < 384) bmT[(ch - 256) * 136 + j] = (bf16_t)f2bf(xc);
        }
    }
    LDS_WAIT(); __syncthreads();
    {
        const int h = w >> 1, pt0 = 2 * (w & 1), g = h >> 1;
        f32x4 acc[2][4];
#pragma unroll
        for (int a = 0; a < 2; ++a)
#pragma unroll
            for (int nt = 0; nt < 4; ++nt) acc[a][nt] = (f32x4){0.f, 0.f, 0.f, 0.f};
#pragma unroll
        for (int ks = 0; ks < 4; ++ks) {
            bf16x8 af[2], bfr[4];
#pragma unroll
            for (int a = 0; a < 2; ++a) af[a] = *(const LAS bf16x8*)(xwT + (64 * h + 16 * (pt0 + a) + fr) * 136 + 32 * ks + 8 * fq);
#pragma unroll
            for (int nt = 0; nt < 4; ++nt) bfr[nt] = *(const LAS bf16x8*)(bmT + (64 * g + 16 * nt + fr) * 136 + 32 * ks + 8 * fq);
#pragma unroll
            for (int a = 0; a < 2; ++a)
#pragma unroll
                for (int nt = 0; nt < 4; ++nt) acc[a][nt] = MFMA16(af[a], bfr[nt], acc[a][nt]);
        }
        float* S = (float*)(P.ws + WS_SLOC) + ((size_t)((b * NCH + c) * 4 + h)) * 4096;
#pragma unroll
        for (int a = 0; a < 2; ++a)
#pragma unroll
            for (int nt = 0; nt < 4; ++nt)
#pragma unroll
                for (int e = 0; e < 4; ++e) S[(16 * (pt0 + a) + 4 * fq + e) * 64 + 16 * nt + fr] = acc[a][nt][e];
        if (tid < 4) ((float*)(P.ws + WS_CD))[(b * NCH + c) * 4 + tid] = __expf(cs[127 * 4 + tid]);
    }
    __syncthreads();
}

__device__ __forceinline__ void carry_phase(const Params& P, int l) {
    const int T = launder_bid() * 512 + launder_tid();
    if (T < 2048) {
        const int b = T >> 10, gn = T & 1023;
        const float* A64 = (const float*)(P.ws + TAB_A64) + ((size_t)l * 1024 + gn) * 2;
        const float ar = A64[0], ai = A64[1];
        const float* E5 = (const float*)(P.ws + ws_e5_off(l)); float* H0 = (float*)(P.ws + WS_H05);
        float hr = 0.f, hi = 0.f;
#pragma unroll 10
        for (int c = 0; c < NCH5; ++c) {
            const size_t idx = (((size_t)b * NCH5 + c) * 1024 + gn) * 2;
#ifdef DBG_S5D
            const float er = __hip_atomic_load((float*)E5 + idx, __ATOMIC_RELAXED, __HIP_MEMORY_SCOPE_AGENT), ei = __hip_atomic_load((float*)E5 + idx + 1, __ATOMIC_RELAXED, __HIP_MEMORY_SCOPE_AGENT);
#else
            const float er = E5[idx], ei = E5[idx + 1];
#endif
            H0[idx] = hr; H0[idx + 1] = hi;
#ifdef DBG_S5E
            const float nr = ar * hr - ai * hi + 0.01f + 0.f * er, ni = ar * hi + ai * hr + 0.02f + 0.f * ei;
#else
            const float nr = ar * hr - ai * hi + er, ni = ar * hi + ai * hr + ei;
#endif
            hr = nr; hi = ni;
        }
        P.out[O_S5RP + ((size_t)l * 2 + b) * 1024 + gn] = hr; P.out[O_S5IP + ((size_t)l * 2 + b) * 1024 + gn] = hi;
    } else if (T < 2048 + 32768) {
        const int gid = T - 2048, b = gid >> 14, h = (gid >> 12) & 3, e = gid & 4095;
        const float* S = (const float*)(P.ws + WS_SLOC); float* HP = (float*)(P.ws + WS_HP); const float* CD = (const float*)(P.ws + WS_CD);
        float hs = 0.f;
#pragma unroll 13
        for (int c = 0; c < NCH; ++c) {
            const size_t idx = ((size_t)((b * NCH + c) * 4 + h)) * 4096 + e;
            const float s = S[idx], cd = CD[(b * NCH + c) * 4 + h];
            HP[idx] = hs;
            hs = cd * hs + s;
        }
        P.out[O_SSDP + ((size_t)(l * 2 + b) * 4 + h) * 4096 + e] = hs;
    }
}

__device__ __forceinline__ void ssd_out_unit(const Params& P, int l, int b, int c, LAS unsigned char* lds) {
    const int tid = launder_tid(), w = __builtin_amdgcn_readfirstlane(tid >> 6), lane = tid & 63, fr = lane & 15, fq = lane >> 4;
    const int pr0 = b * BPAD + 128 * c;
    LAS bf16_t* xsT = (LAS bf16_t*)lds;
    LAS bf16_t* scw = (LAS bf16_t*)(lds + 69632 + w * 4352);
    LAS float* cs = (LAS float*)(lds + 104448);
    LAS float* dts = (LAS float*)(lds + 106496);
    LAS float* ssq4 = (LAS float*)(lds + 108544);
    const bf16_t* XC = (const bf16_t*)(P.ws + WS_XC);
#pragma unroll
    for (int it = 0; it < 8; ++it) {
        const int chunk = it * 512 + tid, j = chunk >> 5, c8 = (chunk & 31) * 8;
        const u32x4 v = *(const u32x4*)(XC + (size_t)(pr0 + j) * 512 + c8);
        xsT[(c8 + 0) * 136 + j] = (bf16_t)(v.x & 0xffff); xsT[(c8 + 1) * 136 + j] = (bf16_t)(v.x >> 16);
        xsT[(c8 + 2) * 136 + j] = (bf16_t)(v.y & 0xffff); xsT[(c8 + 3) * 136 + j] = (bf16_t)(v.y >> 16);
        xsT[(c8 + 4) * 136 + j] = (bf16_t)(v.z & 0xffff); xsT[(c8 + 5) * 136 + j] = (bf16_t)(v.z >> 16);
        xsT[(c8 + 6) * 136 + j] = (bf16_t)(v.w & 0xffff); xsT[(c8 + 7) * 136 + j] = (bf16_t)(v.w >> 16);
    }
    cs[tid] = ((const float*)(P.ws + WS_CS))[(size_t)pr0 * 4 + tid];
    dts[tid] = ((const float*)(P.ws + WS_DTS))[(size_t)pr0 * 4 + tid];
    LDS_WAIT(); __syncthreads();
    const int h = w >> 1, half = w & 1, g = h >> 1;
    const float* hp = (const float*)(P.ws + WS_HP) + ((size_t)((b * NCH + c) * 4 + h)) * 4096;
    bf16x8 hpf[4][2];
#pragma unroll
    for (int pt = 0; pt < 4; ++pt)
#pragma unroll
        for (int ks = 0; ks < 2; ++ks) hpf[pt][ks] = ld_bf16x8_f32(hp + (16 * pt + fr) * 64 + 32 * ks + 8 * fq);
    const float Dh = P.in[I_SSDD][l * 4 + h];
    const bf16_t* Zb = (const bf16_t*)(P.ws + WS_Z);
    f32x4 yg[4][4];
#pragma unroll
    for (int strip = 0; strip < 4; ++strip) {
        const int i0 = 64 * half + 16 * strip, it = i0 >> 4;
        bf16x8 cmf[2];
#pragma unroll
        for (int ks = 0; ks < 2; ++ks) cmf[ks] = *(const bf16x8*)(XC + (size_t)(pr0 + i0 + fr) * 512 + 384 + 64 * g + 32 * ks + 8 * fq);
        f32x4 acc[4];
#pragma unroll
        for (int pt = 0; pt < 4; ++pt) { acc[pt] = (f32x4){0.f, 0.f, 0.f, 0.f};
#pragma unroll
            for (int ks = 0; ks < 2; ++ks) acc[pt] = MFMA16(cmf[ks], hpf[pt][ks], acc[pt]); }
        float csi[4];
#pragma unroll
        for (int e = 0; e < 4; ++e) { csi[e] = cs[(i0 + 4 * fq + e) * 4 + h]; const float ex = __expf(csi[e]);
#pragma unroll
            for (int pt = 0; pt < 4; ++pt) acc[pt][e] *= ex; }
        const int njt = (it | 1) + 1;
        for (int jt = 0; jt < njt; ++jt) {
            f32x4 sc = {0.f, 0.f, 0.f, 0.f};
#pragma unroll
            for (int ks = 0; ks < 2; ++ks) { const bf16x8 bmf = *(const bf16x8*)(XC + (size_t)(pr0 + 16 * jt + fr) * 512 + 256 + 64 * g + 32 * ks + 8 * fq); sc = MFMA16(cmf[ks], bmf, sc); }
            const int j = 16 * jt + fr; const float csj = cs[j * 4 + h], dj = dts[j * 4 + h];
#pragma unroll
            for (int e = 0; e < 4; ++e) { const int i = i0 + 4 * fq + e; const float v = (j <= i) ? sc[e] * __expf(csi[e] - csj) * dj : 0.f; scw[(4 * fq + e) * 136 + j] = (bf16_t)f2bf(v); }
        }
        LDS_WAIT(); asm volatile("" ::: "memory"); __syncthreads();
        for (int ks = 0; ks < (njt >> 1); ++ks) {
            const bf16x8 af = *(const LAS bf16x8*)(scw + fr * 136 + 32 * ks + 8 * fq);
#pragma unroll
            for (int pt = 0; pt < 4; ++pt) { const bf16x8 xf = *(const LAS bf16x8*)(xsT + (64 * h + 16 * pt + fr) * 136 + 32 * ks + 8 * fq); acc[pt] = MFMA16(af, xf, acc[pt]); }
        }
        float qs[4] = {0.f, 0.f, 0.f, 0.f};
#pragma unroll
        for (int pt = 0; pt < 4; ++pt)
#pragma unroll
            for (int e = 0; e < 4; ++e) {
                const int i = i0 + 4 * fq + e, p = 16 * pt + fr;
                const float xs = bf2f(xsT[(64 * h + p) * 136 + i]);
                const float z = bf2f(Zb[(size_t)(pr0 + i) * 256 + 64 * h + p]);
                const float v = (acc[pt][e] + Dh * xs) * siluf_(z);
                yg[strip][pt][e] = v; qs[e] += v * v;
            }
#pragma unroll
        for (int e = 0; e < 4; ++e) {
            float p = qs[e]; p += __shfl_xor(p, 1); p += __shfl_xor(p, 2); p += __shfl_xor(p, 4); p += __shfl_xor(p, 8);
            if (fr == 0) ssq4[(i0 + 4 * fq + e) * 4 + h] = p;
        }
        LDS_WAIT(); asm volatile("" ::: "memory"); __syncthreads();
    }
    __syncthreads();
    bf16_t* MIX = (bf16_t*)(P.ws + WS_MIX);
#pragma unroll
    for (int strip = 0; strip < 4; ++strip)
#pragma unroll
        for (int e = 0; e < 4; ++e) {
            const int i = 64 * half + 16 * strip + 4 * fq + e;
            const int r = pr_to_row(pr0 + i);
            const f32x4 t4 = *(const LAS f32x4*)(ssq4 + i * 4);
            const float rs = rsqrtf(((t4.x + t4.y) + (t4.z + t4.w)) * (1.0f / 256.0f) + EPS);
#pragma unroll
            for (int pt = 0; pt < 4; ++pt) {
                const int col = 64 * h + 16 * pt + fr;
                if (r >= 0) MIX[(size_t)r * DM + 768 + col] = (bf16_t)f2bf(yg[strip][pt][e] * rs * P.in[I_SSDG][l * 256 + col]);
            }
        }
    __syncthreads();
}

__device__ __forceinline__ void ssd_sample_unit(const Params& P, int l, int i, LAS unsigned char* lds) {
    const int tid = launder_tid(), lane = tid & 63, w = tid >> 6, pr = PR_SAMP + i;
    LAS float* xc = (LAS float*)lds;
    LAS float* ys = xc + 512;
    LAS float* red = ys + 256;
    {
        const int ch = tid;
        const float* cst = P.in[I_CONV] + ((size_t)l * 128 + i) * 3 * 512;
        const float s0 = cst[ch], s1 = cst[512 + ch], s2 = cst[1024 + ch];
        const float xn = bf2f(((const bf16_t*)(P.ws + WS_XBC))[(size_t)pr * 512 + ch]);
        const float v = P.in[I_CONVB][l * 512 + ch] + P.in[I_CONVW][(l * 4 + 0) * 512 + ch] * s0 + P.in[I_CONVW][(l * 4 + 1) * 512 + ch] * s1
                      + P.in[I_CONVW][(l * 4 + 2) * 512 + ch] * s2 + P.in[I_CONVW][(l * 4 + 3) * 512 + ch] * xn;
        xc[ch] = siluf_(v);
        float* oc = P.out + O_CONVS + ((size_t)l * 128 + i) * 3 * 512;
        oc[ch] = s1; oc[512 + ch] = s2;
    }
    LDS_WAIT(); __syncthreads();
    const float* DT = (const float*)(P.ws + WS_DT) + (size_t)pr * 4;
    const float* h0 = P.in[I_SSD] + ((size_t)l * 128 + i) * 16384; float* hout = P.out + O_SSDS + ((size_t)l * 128 + i) * 16384;
    for (int k = 0; k < 32; ++k) {
        const int rowi = w + 8 * k, h = rowi >> 6, p = rowi & 63, g = h >> 1;
        const float dt = softplusf_(DT[h] + P.in[I_DTB][l * 4 + h]);
        const float dA = __expf(-__expf(P.in[I_ALOG][l * 4 + h]) * dt);
        const float xs = xc[64 * h + p], bm = xc[256 + 64 * g + lane], cm = xc[384 + 64 * g + lane];
        const float hn = dA * h0[rowi * 64 + lane] + bm * dt * xs;
        hout[rowi * 64 + lane] = hn;
        const float y = wave_sum(cm * hn);
        if (lane == 0) ys[rowi] = y + P.in[I_SSDD][l * 4 + h] * xs;
    }
    LDS_WAIT(); __syncthreads();
    float v = 0.f;
    if (tid < 256) v = ys[tid] * siluf_(bf2f(((const bf16_t*)(P.ws + WS_Z))[(size_t)pr * 256 + tid]));
    const float qs = wave_sum(v * v);
    if (lane == 0) red[w] = qs;
    LDS_WAIT(); __syncthreads();
    const float tot = (red[0] + red[1]) + (red[2] + red[3]);
    const float rs = rsqrtf(tot * (1.0f / 256.0f) + EPS);
    if (tid < 256) ((bf16_t*)(P.ws + WS_MIX))[(size_t)(R_SAMP + i) * DM + 768 + tid] = (bf16_t)f2bf(v * rs * P.in[I_SSDG][l * 256 + tid]);
    __syncthreads();
}

__device__ __forceinline__ void final_phase(const Params& P) {
    const int lane = launder_tid() & 63, gw = launder_bid() * 8 + (launder_tid() >> 6), NGW = launder_gdim() * 8;
    const float* XF = (const float*)(P.ws + WS_XF); const float* ssq = (const float*)(P.ws + WS_SSQ); const float* g = P.in[I_LNF];
    for (int r = gw; r < R_VALID; r += NGW) {
        if (r >= R_META && r < R_SAMP) continue;
        float* o = r < R_META ? P.out + O_Y + (size_t)r * DM : P.out + O_YS + (size_t)(r - R_SAMP) * DM;
        const float rs = row_rs(ssq, r);
#pragma unroll
        for (int j = 0; j < 4; ++j) {
            const f32x4 v = *(const f32x4*)(XF + (size_t)r * DM + 256 * j + 4 * lane), gg = *(const f32x4*)(g + 256 * j + 4 * lane);
#ifdef DBG_OUTE5
            { const size_t fi = (size_t)r * DM + 256 * j + 4 * lane; const float* E5 = (const float*)(P.ws + DBG_OUTE5);
              f32x4 ev = {0.f, 0.f, 0.f, 0.f}; if (r < R_META && fi < (size_t)(DBG_OUTN)) ev = *(const f32x4*)(E5 + fi) * 3000.0f;
              *(f32x4*)(o + 256 * j + 4 * lane) = ev + 0.f * (v * rs * gg); }
#elif defined(DBG_OUTMIX)
            const u32x2 mw = *(const u32x2*)((const bf16_t*)(P.ws + WS_MIX) + (size_t)r * DM + 256 * j + 4 * lane);
            f32x4 mv = {bflo(mw.x), bfhi(mw.x), bflo(mw.y), bfhi(mw.y)};
            *(f32x4*)(o + 256 * j + 4 * lane) = mv + 0.f * (v * rs * gg);
#else
            *(f32x4*)(o + 256 * j + 4 * lane) = v * rs * gg;
#endif
        }
    }
}

#define XB_TMO      128
#define XB_XCNT(j)  (256  + 64 * (j))
#define XB_XSUB(j)  (1280 + 64 * (j))
#define XB_XGEN(j)  (2304 + 64 * (j))
#define XB_TOP      3328
#define XB_TOPGEN   3392
#define XCD_BAR_WORDS 3456
#define XB_SPIN_CAP (1u << 18)

__device__ __forceinline__ unsigned xb_ld(unsigned* p)              { return __hip_atomic_load(p, __ATOMIC_RELAXED, __HIP_MEMORY_SCOPE_AGENT); }
__device__ __forceinline__ unsigned xb_add(unsigned* p, unsigned v) { return __hip_atomic_fetch_add(p, v, __ATOMIC_RELAXED, __HIP_MEMORY_SCOPE_AGENT); }
__device__ __forceinline__ unsigned xb_xcc_id() { return (unsigned)__builtin_amdgcn_s_getreg((3 << 11) | 20) & 0xFu; }
#define XB_SPIN(cond, bar) do { unsigned _sp = 0; while (cond) { __builtin_amdgcn_s_sleep(1); \
    if ((++_sp & 255u) == 0u) { if (xb_ld(&(bar)[XB_TMO])) break; if (_sp > XB_SPIN_CAP) { atomicAdd(&(bar)[XB_TMO], 1u); break; } } } } while (0)

struct XcdBarrier {
    unsigned* bar; unsigned x;
    volatile LAS unsigned* st;
};

__device__ __forceinline__ XcdBarrier xcd_barrier_post(unsigned* bar, volatile LAS unsigned* st) {
    XcdBarrier b; b.bar = bar; b.x = xb_xcc_id(); b.st = st;
    if (threadIdx.x == 0) (void)xb_add(&bar[XB_XCNT(b.x)], 1u);
    return b;
}
__device__ __forceinline__ void xcd_barrier_complete(unsigned* bar, unsigned x, unsigned& nloc, unsigned& nx) {
    const unsigned G = gridDim.x * gridDim.y * gridDim.z;
    unsigned sum, cnt, mine, sp = 0u;
    for (;;) {
        sum = 0u; cnt = 0u; mine = 0u;
#pragma unroll
        for (unsigned j = 0; j < 16; ++j) { const unsigned c = xb_ld(&bar[XB_XCNT(j)]); sum += c; cnt += (c > 0u) ? 1u : 0u; mine = (j == x) ? c : mine; }
        if (sum == G) break;
        __builtin_amdgcn_s_sleep(1);
        if ((++sp & 255u) == 0u) { if (xb_ld(&bar[XB_TMO])) break; if (sp > XB_SPIN_CAP) { atomicAdd(&bar[XB_TMO], 1u); break; } }
    }
    nloc = mine > 0u ? mine : 1u; nx = cnt > 0u ? cnt : 1u;
}

__device__ __forceinline__ void xcd_barrier(const XcdBarrier& b) {
    asm volatile("s_waitcnt vmcnt(0)" ::: "memory");
    __syncthreads();
    if (threadIdx.x == 0) {
        unsigned* bar = b.bar;
        __builtin_amdgcn_s_waitcnt(0);
        unsigned nloc = b.st[0], nx = b.st[1];
        if (nloc == 0u) { xcd_barrier_complete(bar, b.x, nloc, nx); b.st[0] = nloc; b.st[1] = nx; }
        const unsigned old = xb_add(&bar[XB_XSUB(b.x)], 1u);
        const unsigned gen = old / nloc;
        if (old + 1u == (gen + 1u) * nloc) {
            __builtin_amdgcn_fence(__ATOMIC_RELEASE, "agent");
            asm volatile("s_waitcnt vmcnt(0)" ::: "memory");
            const unsigned og = xb_add(&bar[XB_TOP], 1u);
            const unsigned tg = og / nx;
            if (og + 1u == (tg + 1u) * nx) xb_add(&bar[XB_TOPGEN], 1u);
            else XB_SPIN(xb_ld(&bar[XB_TOPGEN]) == tg, bar);
            __builtin_amdgcn_fence(__ATOMIC_ACQUIRE, "agent");
            xb_add(&bar[XB_XGEN(b.x)], 1u);
            asm volatile("s_waitcnt vmcnt(0)" ::: "memory");
        } else {
            XB_SPIN(xb_ld(&bar[XB_XGEN(b.x)]) == gen, bar);
            __builtin_amdgcn_fence(__ATOMIC_ACQUIRE, "agent");
            asm volatile("s_waitcnt vmcnt(0)" ::: "memory");
        }
    }
    __syncthreads();
}

constexpr int LDS_MISC = 131072 + 8192;
constexpr int N_PHASES = 30;
#ifndef MK_ONE_LAUNCH
#define MK_ONE_LAUNCH 0
#endif
#ifndef PG_SP2
#define PG_SP2 true
#endif

__device__ __forceinline__ void run_phase(const Params& P, int ph, LAS unsigned char* lds) {
    unsigned char* ws = P.ws;
    if (ph == 0) { phase_prologue(P, lds); return; }
    if (ph == N_PHASES - 1) { final_phase(P); return; }
    const int l = (ph - 1) / 7, k = (ph - 1) % 7;
    const int G = launder_gdim(), bx = launder_bid();
    switch (k) {
    case 0: {
        pg8::Gemm g{(const bf16_t*)(ws + WS_XB), (const bf16_t*)(ws + WS_WIN) + (size_t)l * NIN * DM, MR, NIN, DM};
        pg8::StaticOrder S; S.init(MR, NIN, G, bx);
        EpiWin E{ws, P.out, l};
        pg8::gemm_phase<EpiWin, pg8::StaticOrder, true, PG_SP2>(lds, g, S, E);
        dt_rows(P, l);
        zero_pads(P, l);
    } break;
    case 1: {
        constexpr int NU = 130 + 260 + 130 + 128;
        for (int u = bx; u < NU; u += G) {
#ifdef DBG_RT
            if (u < 130) { if (!(P.dbg & 1)) continue; } else if (u >= 390 && u < 520) { if (P.dbg & 64) continue; } else if (u >= 520) { if (P.dbg & 128) continue; }
#endif
            if (u < 130) attn_prompt_unit(P, l, u / NCH, u % NCH, lds);
            else if (u < 390) { const int v = u - 130; s5_unit<false>(P, l, v / NCH5, v % NCH5, lds); }
            else if (u < 520) { const int v = u - 390; ssd_local_unit(P, l, v / NCH, v % NCH, lds); }
            else attn_sample_unit(P, l, u - 520, lds);
        }
    } break;
    case 2: carry_phase(P, l); break;
    case 3: {
        constexpr int NU = 260 + 130 + 128 + 128;
        for (int u = bx; u < NU; u += G) {
#ifdef DBG_RT
            if (u < 260) { if (!(P.dbg & 2)) continue; } else if (u < 390) { if (!(P.dbg & 4)) continue; }
#endif
            if (u < 260) s5_unit<true>(P, l, u / NCH5, u % NCH5, lds);
            else if (u < 390) { const int v = u - 260; ssd_out_unit(P, l, v / NCH, v % NCH, lds); }
            else if (u < 518) s5_sample_unit(P, l, u - 390, lds);
            else ssd_sample_unit(P, l, u - 518, lds);
        }
    } break;
    case 4: {
        pg8::Gemm g{(const bf16_t*)(ws + WS_MIX), (const bf16_t*)(ws + WS_WOUT) + (size_t)l * DM * DM, MR, DM, DM};
        pg8::StaticOrder S; S.init(MR, DM, G, bx);
        EpiRes E{ws, (LAS float*)(lds + LDS_RED)};
        pg8::gemm_phase<EpiRes, pg8::StaticOrder, true, PG_SP2>(lds, g, S, E);
    } break;
    case 5: {
        pg8::Gemm g{(const bf16_t*)(ws + WS_XB), (const bf16_t*)(ws + WS_WGU) + (size_t)l * NGU * DM, MR, NGU, DM};
        pg8::StaticOrder S; S.init(MR, NGU, G, bx);
        EpiGU E{ws};
        pg8::gemm_phase<EpiGU, pg8::StaticOrder, true, PG_SP2>(lds, g, S, E);
    } break;
    default: {
        pg8::Gemm g{(const bf16_t*)(ws + WS_H), (const bf16_t*)(ws + WS_WDN) + (size_t)l * DM * FFN, MR, DM, FFN};
        pg8::StaticOrder S; S.init(MR, DM, G, bx);
        EpiRes E{ws, (LAS float*)(lds + LDS_RED)};
        pg8::gemm_phase<EpiRes, pg8::StaticOrder, true, PG_SP2>(lds, g, S, E);
    } break;
    }
}

__global__ void __launch_bounds__(512, 2) fwd_kernel(Params P) {
    extern __shared__ __attribute__((aligned(16))) unsigned char lds_raw[];
    LAS unsigned char* lds = (LAS unsigned char*)lds_raw;
    cg::grid_group grid = cg::this_grid();
    volatile LAS unsigned* bst = (volatile LAS unsigned*)(lds + LDS_MISC);
    if (launder_tid() < 2) bst[launder_tid()] = 0u;
    __syncthreads();
    XcdBarrier xbar = xcd_barrier_post((unsigned*)(P.ws + WS_CTL), bst);
    for (int ph = P.ph_lo; ph < P.ph_hi; ++ph) {
        if (ph == P.ph_lo + 1) {
            asm volatile("s_waitcnt vmcnt(0) lgkmcnt(0)" ::: "memory");
            __syncthreads();
            __threadfence();
            asm volatile("s_waitcnt vmcnt(0)" ::: "memory");
            grid.sync();
            __threadfence();
            asm volatile("s_waitcnt vmcnt(0)" ::: "memory");
            __syncthreads();
        } else if (ph > P.ph_lo) {
            xcd_barrier(xbar);
        }
        auto kp = __builtin_amdgcn_kernarg_segment_ptr();
        asm volatile("" : "+s"(kp));
        run_phase(*(const Params*)kp, ph, lds);
    }
}

extern "C" void kernel_launch(void* const* d_in, const int* in_sizes, int n_in, void* d_out, int out_size, void* d_ws, size_t ws_size, hipStream_t stream) {
    static int grid = 0;
    if (grid == 0) {
        if (n_in != 36 || (size_t)out_size != O_END || ws_size < WS_END) {
            fprintf(stderr, "kernel_launch: unexpected problem: n_in %d out %d ws %zu (need %zu)\n", n_in, out_size, ws_size, (size_t)WS_END); grid = -1; return;
        }
        int dev = 0, cus = 0, per_cu = 0;
        (void)hipGetDevice(&dev);
        (void)hipDeviceGetAttribute(&cus, hipDeviceAttributeMultiprocessorCount, dev);
        (void)hipFuncSetAttribute((const void*)fwd_kernel, hipFuncAttributeMaxDynamicSharedMemorySize, LDS_BYTES);
        (void)hipOccupancyMaxActiveBlocksPerMultiprocessor(&per_cu, (const void*)fwd_kernel, 512, LDS_BYTES);
        if (per_cu < 1) { fprintf(stderr, "kernel_launch: occupancy query says %d blocks per CU\n", per_cu); per_cu = 1; }
        (void)hipGetLastError();
        grid = cus;
    }
    if (grid < 0) return;
#ifdef DBG_POISON_LO
    (void)hipMemsetAsync((char*)d_ws + (size_t)(DBG_POISON_LO) * MiB, 0xAA, (size_t)(DBG_POISON_HI - DBG_POISON_LO) * MiB, stream);
#endif
    (void)hipMemsetAsync((char*)d_ws + WS_CTL, 0, 65536, stream);
    Params p{};
    for (int i = 0; i < 36; ++i) p.in[i] = (const float*)d_in[i];
    p.out = (float*)d_out; p.ws = (unsigned char*)d_ws;
#ifdef DBG_RT
    p.dbg = DBG_RT;
#endif
#if MK_ONE_LAUNCH
    p.ph_lo = 0; p.ph_hi = N_PHASES;
    void* args[] = {&p};
    hipError_t e = hipLaunchCooperativeKernel((const void*)fwd_kernel, dim3(grid), dim3(512), args, LDS_BYTES, stream);
    if (e != hipSuccess) fprintf(stderr, "cooperative launch failed: %s (grid %d)\n", hipGetErrorString(e), grid);
#ifdef DBG_TWICE
    e = hipLaunchCooperativeKernel((const void*)fwd_kernel, dim3(grid), dim3(512), args, LDS_BYTES, stream);
#endif
#else
    for (int ph = 0; ph < N_PHASES; ++ph) {
#ifdef DBG_PHASES
        if (!(ph == 0 || ph == N_PHASES - 1 || (ph < DBG_PHASES))) continue;
#endif
        p.ph_lo = ph; p.ph_hi = ph + 1;
        hipLaunchKernelGGL(fwd_kernel, dim3(grid), dim3(512), LDS_BYTES, stream, p);
    }
#endif
}
```
